# Optimizing an MI355X kernel written in HIP

```python
import math
import jax, jax.numpy as jnp
from jax import lax
import numpy as np

D_MODEL = 2048
BATCH = 16
SEQ = 2048
DEPTH = 4

N_MIXERS = 3
EPS = 1e-6
GN_EPS = 1e-5

CONV_WIDTH = D_MODEL
CONV_K = 3

RET_HEADS = 8
RET_QK_DIM = D_MODEL // RET_HEADS
RET_V_DIM = 2 * D_MODEL // RET_HEADS
RET_QK_WIDTH = RET_HEADS * RET_QK_DIM
RET_WIDTH = RET_HEADS * RET_V_DIM
RET_CHUNK = 128
ROPE_BASE = 10000.0

SB_HEADS = 16
SB_HEAD_DIM = D_MODEL // SB_HEADS
SB_WIDTH = SB_HEADS * SB_HEAD_DIM
SB_BLOCK = 128

N_CONV = (DEPTH + 2) // 3
N_RET = (DEPTH + 1) // 3
N_SB = DEPTH // 3

kernel_name = "hybrid_conv_retention_stickbreak"


def rmsnorm(x, g):
    xf = x.astype(jnp.float32)
    y = xf * lax.rsqrt(jnp.mean(xf * xf, axis=-1, keepdims=True) + EPS) * g.astype(jnp.float32)
    return y.astype(x.dtype)


def rms_f32(x, g):
    xf = x.astype(jnp.float32)
    return xf * lax.rsqrt(jnp.mean(xf * xf, axis=-1, keepdims=True) + EPS) * g.astype(jnp.float32)


def split_heads(t, n_heads, head_dim):
    b, s, _ = t.shape
    return t.reshape(b, s, n_heads, head_dim).transpose(0, 2, 1, 3)


def rotary(x, pos):
    half = x.shape[-1] // 2
    inv_freq = ROPE_BASE ** (-jnp.arange(half, dtype=jnp.float32) / half)
    ang = pos.astype(jnp.float32)[:, None] * inv_freq[None, :]
    cos, sin = jnp.cos(ang), jnp.sin(ang)
    x1, x2 = x[..., :half], x[..., half:]
    return jnp.concatenate([x1 * cos - x2 * sin, x2 * cos + x1 * sin], axis=-1)


def short_conv_mixer(h, w_in, conv_w, conv_b, w_out):
    s = h.shape[1]
    proj = h @ w_in
    b_gate, c_gate, u, g = jnp.split(proj, 4, axis=-1)
    v = c_gate * u
    vp = jnp.pad(v, ((0, 0), (CONV_K - 1, 0), (0, 0)))
    conv = conv_b + vp[:, 0:s, :] * conv_w[0]
    for k in range(1, CONV_K):
        conv = conv + vp[:, k:k + s, :] * conv_w[k]
    y = b_gate * conv * jax.nn.silu(g)
    return y @ w_out


def retention_mixer(h, w_in, q_gain, k_gain, gn_w, gn_b, w_out):
    bsz, s, _ = h.shape
    proj = h @ w_in
    q, k, v, g = jnp.split(proj, [RET_QK_WIDTH, 2 * RET_QK_WIDTH, 2 * RET_QK_WIDTH + RET_WIDTH], axis=-1)
    pos = jnp.arange(s)
    q = rotary(rms_f32(split_heads(q, RET_HEADS, RET_QK_DIM), q_gain), pos)
    k = rotary(rms_f32(split_heads(k, RET_HEADS, RET_QK_DIM), k_gain), pos) * (RET_QK_DIM ** -0.5)
    v = split_heads(v, RET_HEADS, RET_V_DIM).astype(jnp.float32)

    log_g = jnp.log(1.0 - jnp.exp2(-5.0 - jnp.arange(RET_HEADS, dtype=jnp.float32)))
    c = RET_CHUNK
    n = s // c
    idx = jnp.arange(c, dtype=jnp.float32)
    diff = idx[:, None] - idx[None, :]
    decay_in = jnp.where(diff >= 0, jnp.exp(log_g[:, None, None] * jnp.maximum(diff, 0.0)), 0.0)
    decay_q = jnp.exp(log_g[:, None] * (idx + 1.0))[..., None]
    decay_k = jnp.exp(log_g[:, None] * (c - 1.0 - idx))[..., None]
    decay_chunk = jnp.exp(log_g * c)[:, None, None]

    def chunks(t):
        return t.reshape(bsz, RET_HEADS, n, c, t.shape[-1]).transpose(2, 0, 1, 3, 4)

    def step(state, inp):
        qi, ki, vi = inp
        inner = jnp.einsum('bhqd,bhkd->bhqk', qi, ki) * decay_in
        o = jnp.einsum('bhqk,bhkv->bhqv', inner, vi) + jnp.einsum('bhqd,bhdv->bhqv', qi, state) * decay_q
        state = state * decay_chunk + jnp.einsum('bhkd,bhkv->bhdv', ki * decay_k, vi)
        return state, o

    state0 = jnp.zeros((bsz, RET_HEADS, RET_QK_DIM, RET_V_DIM), jnp.float32)
    _, o = lax.scan(step, state0, (chunks(q), chunks(k), chunks(v)))
    o = o.transpose(1, 2, 0, 3, 4).reshape(bsz, RET_HEADS, s, RET_V_DIM)
    mu = jnp.mean(o, axis=-1, keepdims=True)
    var = jnp.mean(jnp.square(o - mu), axis=-1, keepdims=True)
    o = (o - mu) * lax.rsqrt(var + GN_EPS)
    o = o.transpose(0, 2, 1, 3).reshape(bsz, s, RET_WIDTH) * gn_w.astype(jnp.float32) + gn_b.astype(jnp.float32)
    y = jax.nn.silu(g) * o.astype(h.dtype)
    return y @ w_out


def stick_breaking_mixer(h, w_in, q_gain, k_gain, w_out):
    bsz, s, _ = h.shape
    proj = h @ w_in
    q, k, v, g = jnp.split(proj, 4, axis=-1)
    q = rms_f32(split_heads(q, SB_HEADS, SB_HEAD_DIM), q_gain) * (SB_HEAD_DIM ** -0.5)
    k = rms_f32(split_heads(k, SB_HEADS, SB_HEAD_DIM), k_gain)
    v = split_heads(v, SB_HEADS, SB_HEAD_DIM).astype(jnp.float32)
    nb = s // SB_BLOCK
    qb = q.reshape(bsz, SB_HEADS, nb, SB_BLOCK, SB_HEAD_DIM).transpose(2, 0, 1, 3, 4)
    kpos = jnp.arange(s)

    def block(args):
        qi, start = args
        z = jnp.einsum('bhqd,bhkd->bhqk', qi, k)
        qpos = start + jnp.arange(SB_BLOCK)
        mask = kpos[None, :] < qpos[:, None]
        log_beta = jax.nn.log_sigmoid(z)
        log_fail = jnp.where(mask, log_beta - z, 0.0)
        after = lax.cumsum(log_fail, axis=3, reverse=True) - log_fail
        w = jnp.where(mask, jnp.exp(log_beta + after), 0.0)
        return jnp.einsum('bhqk,bhkd->bhqd', w, v)

    o = lax.map(block, (qb, jnp.arange(nb) * SB_BLOCK))
    o = o.transpose(1, 0, 3, 2, 4).reshape(bsz, s, SB_WIDTH)
    y = jax.nn.silu(g) * o.astype(h.dtype)
    return y @ w_out


def setup_inputs(seed: int = 0) -> dict:
    key = jax.random.key(seed)
    ks = jax.random.split(key, 24)
    f32 = jnp.float32

    def nrm(k, shape, scale):
        return jax.random.normal(k, shape, f32) * scale

    def gain(k, shape):
        return 1.0 + 0.02 * jax.random.normal(k, shape, f32)

    out_scale = 0.5
    return {
        "x": jax.random.normal(ks[0], (BATCH, SEQ, D_MODEL), f32),
        "conv_norm": gain(ks[1], (N_CONV, D_MODEL)),
        "conv_w_in": nrm(ks[2], (N_CONV, D_MODEL, 4 * CONV_WIDTH), D_MODEL ** -0.5),
        "conv_w": nrm(ks[3], (N_CONV, CONV_K, CONV_WIDTH), CONV_K ** -0.5),
        "conv_b": nrm(ks[4], (N_CONV, CONV_WIDTH), 0.02),
        "conv_w_out": nrm(ks[5], (N_CONV, CONV_WIDTH, D_MODEL), out_scale * CONV_WIDTH ** -0.5),
        "ret_norm": gain(ks[6], (N_RET, D_MODEL)),
        "ret_w_in": nrm(ks[7], (N_RET, D_MODEL, 2 * RET_QK_WIDTH + 2 * RET_WIDTH), D_MODEL ** -0.5),
        "ret_q_gain": gain(ks[8], (N_RET, RET_QK_DIM)),
        "ret_k_gain": gain(ks[9], (N_RET, RET_QK_DIM)),
        "ret_gn_w": gain(ks[10], (N_RET, RET_WIDTH)),
        "ret_gn_b": nrm(ks[11], (N_RET, RET_WIDTH), 0.02),
        "ret_w_out": nrm(ks[12], (N_RET, RET_WIDTH, D_MODEL), out_scale * RET_WIDTH ** -0.5),
        "sb_norm": gain(ks[13], (N_SB, D_MODEL)),
        "sb_w_in": nrm(ks[14], (N_SB, D_MODEL, 4 * SB_WIDTH), D_MODEL ** -0.5),
        "sb_q_gain": gain(ks[15], (N_SB, SB_HEAD_DIM)),
        "sb_k_gain": gain(ks[16], (N_SB, SB_HEAD_DIM)),
        "sb_w_out": nrm(ks[17], (N_SB, SB_WIDTH, D_MODEL), out_scale * SB_WIDTH ** -0.5),
    }


def reference(x, conv_norm, conv_w_in, conv_w, conv_b, conv_w_out,
              ret_norm, ret_w_in, ret_q_gain, ret_k_gain, ret_gn_w, ret_gn_b, ret_w_out,
              sb_norm, sb_w_in, sb_q_gain, sb_k_gain, sb_w_out):
    for i in range(DEPTH):
        kind = i % N_MIXERS
        j = i // N_MIXERS
        if kind == 0:
            h = rmsnorm(x, conv_norm[j])
            x = x + short_conv_mixer(h, conv_w_in[j], conv_w[j], conv_b[j], conv_w_out[j])
        elif kind == 1:
            h = rmsnorm(x, ret_norm[j])
            x = x + retention_mixer(h, ret_w_in[j], ret_q_gain[j], ret_k_gain[j],
                                    ret_gn_w[j], ret_gn_b[j], ret_w_out[j])
        else:
            h = rmsnorm(x, sb_norm[j])
            x = x + stick_breaking_mixer(h, sb_w_in[j], sb_q_gain[j], sb_k_gain[j], sb_w_out[j])
    return x
```

```cpp
#include <hip/hip_runtime.h>
#include <hip/hip_cooperative_groups.h>
#include <hip/amd_detail/amd_hip_unsafe_atomics.h>
#include <cstdio>
#include <cstdint>
namespace cg = cooperative_groups;
namespace pg8 {
#define PG8_LAS __attribute__((address_space(3)))
typedef unsigned short bf16_t;
typedef short bf16x8 __attribute__((ext_vector_type(8)));
typedef float f32x4 __attribute__((ext_vector_type(4)));
typedef unsigned u32x4 __attribute__((ext_vector_type(4)));
constexpr int BM = 256, BK = 64, HALF = 128, HTB = HALF * BK * 2  , STAGE_BYTES = 8 * HTB, NXCD = 8, WGM = 8;

__host__ __device__ __forceinline__ int lds_byte(int r, int c) { const int st = (r >> 4) * 2 + (c >> 5), rr = r & 15, cc = c & 31, ob = rr * 64 + cc * 2; return st * 1024 + (ob ^ (((ob >> 9) & 1) << 5)); }
__host__ __device__ __forceinline__ void stage_rc(int b, int& R, int& C) { const int st = b / 1024, sb = b % 1024, swz = sb ^ (((sb >> 9) & 1) << 5); R = (st >> 1) * 16 + swz / 64; C = (st & 1) * 32 + (swz % 64) / 2; }
__host__ __device__ __forceinline__ int perm32(int rho) { const int n = rho >> 4, i = rho & 15; return 8 * (i >> 2) + 4 * n + (i & 3); }

struct Unit { int pm, pn; };
struct Gemm { const bf16_t* A; const bf16_t* Bt; int M, N, K; };

struct StaticOrder {
    int nM, nN, nwg, G, c;
    __host__ __device__ void init(int M, int N, int G_, int c_) { nM = M / BM; nN = N / BM; nwg = nM * nN; G = G_; c = c_; }
    __host__ __device__ bool next(int i, Unit& u) const {
        const long L = (long)i * G + c; if (L >= nwg) return false;
        int wgid = (int)L; { const int q = nwg / NXCD, r = nwg % NXCD, xcd = wgid % NXCD, off = wgid / NXCD; wgid = (xcd < r ? xcd * (q + 1) : r * (q + 1) + (xcd - r) * q) + off; }
        const int nig = WGM * nN, gid = wgid / nig, fm = gid * WGM, gsz = (nM - fm) < WGM ? (nM - fm) : WGM;
        u.pm = fm + ((wgid % nig) % gsz); u.pn = (wgid % nig) / gsz; return true;
    }
    __device__ __forceinline__ void a_ready(const Unit&) const {}
    __device__ __forceinline__ void done(const Unit&) const {}
};

typedef __bf16 bf2_t __attribute__((ext_vector_type(2)));
typedef float f32x2 __attribute__((ext_vector_type(2)));
__device__ __forceinline__ unsigned cvt_pk_bf16(float lo, float hi) { f32x2 v = {lo, hi}; return __builtin_bit_cast(unsigned, __builtin_convertvector(v, bf2_t)); }
template <class Epi, class Sched, bool ALIGN_EPI = false, bool SP2 = false>
__device__ __forceinline__ void gemm_phase(PG8_LAS unsigned char* lds, const Gemm g, const Sched& S, const Epi& E) {
    const int tid = threadIdx.x, wid = __builtin_amdgcn_readfirstlane(tid >> 6), lane = tid & 63, wr = wid >> 2, wc = wid & 3, fr = lane & 15, fq = lane >> 4;
    const int K = g.K, nt = K / BK;
    unsigned voffA[2], voffB[2];
#pragma unroll
    for (int i = 0; i < 2; ++i) { int R, C; stage_rc(tid * 16 + i * 8192, R, C); const int Rb = Epi::PERM ? ((R & ~31) + perm32(R & 31)) : R;
        voffA[i] = (unsigned)(R * K + C) * 2u; voffB[i] = (unsigned)(Rb * K + C) * 2u; }
    const size_t kstep = (size_t)(BK * 2);
    const size_t hstep = (size_t)HALF * K * 2;
    const size_t tstep = 2 * hstep;
    const unsigned ldsw = (unsigned)wid * 1024u;
    const int aoff = lds_byte(wr * 64 + fr, fq * 8), boff = lds_byte(wc * 32 + fr, fq * 8);
#define PG8_SA(b, h) (((b) * 2 + (h)) * HTB)
#define PG8_SB(b, h) ((4 + (b) * 2 + (h)) * HTB)
#define PG8_STAGE(bufoff, gbase, voff) do { _Pragma("unroll") for (int _i = 0; _i < 2; ++_i) \
        __builtin_amdgcn_global_load_lds((const unsigned*)((const char*)(gbase) + (voff)[_i]), (PG8_LAS unsigned*)(lds + (bufoff) + ldsw + _i * 8192), 16, 0, 0); } while (0)
#define PG8_LDA(dst, b, h) do { _Pragma("unroll") for (int m = 0; m < 4; ++m) _Pragma("unroll") for (int k = 0; k < 2; ++k) dst[m][k] = *(const PG8_LAS bf16x8*)(lds + PG8_SA(b, h) + aoff + m * 2048 + k * 1024); } while (0)
#define PG8_LDB(dst, b, h) do { _Pragma("unroll") for (int n = 0; n < 2; ++n) _Pragma("unroll") for (int k = 0; k < 2; ++k) dst[n][k] = *(const PG8_LAS bf16x8*)(lds + PG8_SB(b, h) + boff + n * 2048 + k * 1024); } while (0)
#define PG8_MMA(ai, bj, At, Bt) do { __builtin_amdgcn_s_setprio(1); _Pragma("unroll") for (int m = 0; m < 4; ++m) _Pragma("unroll") for (int n = 0; n < 2; ++n) _Pragma("unroll") for (int k = 0; k < 2; ++k) \
        acc[ai][bj][m][n] = __builtin_amdgcn_mfma_f32_16x16x32_bf16(Bt[n][k], At[m][k], acc[ai][bj][m][n], 0, 0, 0); __builtin_amdgcn_s_setprio(0); } while (0)
#define PG8_WAIT_V(n) asm volatile("s_waitcnt vmcnt(" #n ")" ::: "memory")
#define PG8_WAIT_L(n) asm volatile("s_waitcnt lgkmcnt(" #n ")" ::: "memory")
#define PG8_BAR __builtin_amdgcn_s_barrier()
#define PG8_SCHED __builtin_amdgcn_sched_barrier(0)
    Unit cur, nxt; int ui = 0;
    if (!S.next(0, cur)) return;
    f32x4 acc[2][2][4][2];
#pragma unroll
    for (int a = 0; a < 2; ++a)
#pragma unroll
        for (int b = 0; b < 2; ++b)
#pragma unroll
            for (int m = 0; m < 4; ++m)
#pragma unroll
                for (int n = 0; n < 2; ++n) acc[a][b][m][n] = (f32x4){0.f, 0.f, 0.f, 0.f};
    bf16x8 At[4][2], B0[2][2], B1[2][2];
    const char* cA = (const char*)g.A + (size_t)cur.pm * tstep; const char* cB = (const char*)g.Bt + (size_t)cur.pn * tstep;
    S.a_ready(cur);
    if constexpr (SP2) {
        PG8_STAGE(PG8_SB(0, 0), cB, voffB); PG8_STAGE(PG8_SB(0, 1), cB + hstep, voffB); PG8_STAGE(PG8_SA(0, 0), cA, voffA); PG8_STAGE(PG8_SA(0, 1), cA + hstep, voffA);
        if (wr == 1) PG8_BAR;
        PG8_WAIT_V(2); PG8_BAR;
        PG8_STAGE(PG8_SB(1, 0), cB + kstep, voffB); PG8_STAGE(PG8_SA(1, 0), cA + kstep, voffA); PG8_STAGE(PG8_SB(1, 1), cB + hstep + kstep, voffB);
        PG8_WAIT_V(6); PG8_BAR;
    } else {
        PG8_STAGE(PG8_SB(0, 0), cB, voffB); PG8_STAGE(PG8_SA(0, 0), cA, voffA); PG8_STAGE(PG8_SB(0, 1), cB + hstep, voffB); PG8_STAGE(PG8_SA(0, 1), cA + hstep, voffA);
        if (wr == 1) PG8_BAR;
        PG8_WAIT_V(4); PG8_BAR;
        PG8_STAGE(PG8_SB(1, 0), cB + kstep, voffB); PG8_STAGE(PG8_SA(1, 0), cA + kstep, voffA); PG8_STAGE(PG8_SB(1, 1), cB + hstep + kstep, voffB);
        PG8_WAIT_V(6); PG8_BAR;
    }
    for (;;) {
        const bool has_next = S.next(ui + 1, nxt);
        const char* nA = has_next ? (const char*)g.A + (size_t)nxt.pm * tstep : cA; const char* nB = has_next ? (const char*)g.Bt + (size_t)nxt.pn * tstep : cB;
        for (int t = 0; t < nt; t += 2) {
            const bool last = (t == nt - 2);
            const char* a1 = cA + (size_t)(t + 1) * kstep;
            const char* a2 = last ? nA : cA + (size_t)(t + 2) * kstep; const char* b2 = last ? nB : cB + (size_t)(t + 2) * kstep;
            const char* a3 = a2 + kstep; const char* b3 = b2 + kstep;
            if (last && has_next) S.a_ready(nxt);
            if constexpr (SP2) {
            PG8_LDB(B0, 0, 0); PG8_LDB(B1, 0, 1); PG8_SCHED; PG8_LDA(At, 0, 0); PG8_STAGE(PG8_SA(1, 1), a1 + hstep, voffA);
            PG8_WAIT_V(8); PG8_WAIT_L(0); PG8_BAR; PG8_MMA(0, 0, At, B0); PG8_MMA(0, 1, At, B1); PG8_BAR; PG8_SCHED;
            PG8_LDA(At, 0, 1); PG8_STAGE(PG8_SB(0, 0), b2, voffB); PG8_STAGE(PG8_SB(0, 1), b2 + hstep, voffB); PG8_STAGE(PG8_SA(0, 0), a2, voffA);
            PG8_WAIT_V(8); PG8_WAIT_L(0); PG8_BAR; PG8_MMA(1, 0, At, B0); PG8_MMA(1, 1, At, B1); PG8_BAR; PG8_SCHED;
            PG8_LDB(B0, 1, 0); PG8_LDB(B1, 1, 1); PG8_SCHED; PG8_LDA(At, 1, 0); PG8_STAGE(PG8_SA(0, 1), a2 + hstep, voffA);
            PG8_WAIT_V(8); PG8_WAIT_L(0); PG8_BAR; PG8_MMA(0, 0, At, B0); PG8_MMA(0, 1, At, B1); PG8_BAR; PG8_SCHED;
            PG8_LDA(At, 1, 1); PG8_STAGE(PG8_SB(1, 0), b3, voffB); PG8_STAGE(PG8_SB(1, 1), b3 + hstep, voffB); PG8_STAGE(PG8_SA(1, 0), a3, voffA);
            PG8_WAIT_V(8); PG8_WAIT_L(0); PG8_BAR; PG8_MMA(1, 0, At, B0); PG8_MMA(1, 1, At, B1); PG8_BAR; PG8_SCHED;
            } else {
            PG8_LDB(B0, 0, 0); PG8_SCHED; PG8_LDA(At, 0, 0); PG8_STAGE(PG8_SA(1, 1), a1 + hstep, voffA);
            PG8_WAIT_L(8); PG8_BAR; PG8_WAIT_L(0); PG8_MMA(0, 0, At, B0); PG8_BAR; PG8_SCHED;
            PG8_LDB(B1, 0, 1); PG8_STAGE(PG8_SB(0, 0), b2, voffB);
            PG8_BAR; PG8_WAIT_L(0); PG8_MMA(0, 1, At, B1); PG8_BAR;
            PG8_LDA(At, 0, 1); PG8_STAGE(PG8_SA(0, 0), a2, voffA);
            PG8_BAR; PG8_WAIT_L(0); PG8_MMA(1, 0, At, B0); PG8_BAR; PG8_SCHED;
            PG8_STAGE(PG8_SB(0, 1), b2 + hstep, voffB);
            PG8_WAIT_V(6); PG8_BAR; PG8_MMA(1, 1, At, B1); PG8_BAR;
            PG8_LDB(B0, 1, 0); PG8_SCHED; PG8_LDA(At, 1, 0); PG8_STAGE(PG8_SA(0, 1), a2 + hstep, voffA);
            PG8_WAIT_L(8); PG8_BAR; PG8_WAIT_L(0); PG8_MMA(0, 0, At, B0); PG8_BAR; PG8_SCHED;
            PG8_LDB(B1, 1, 1); PG8_STAGE(PG8_SB(1, 0), b3, voffB);
            PG8_BAR; PG8_WAIT_L(0); PG8_MMA(0, 1, At, B1); PG8_BAR;
            PG8_LDA(At, 1, 1); PG8_STAGE(PG8_SA(1, 0), a3, voffA);
            PG8_BAR; PG8_WAIT_L(0); PG8_MMA(1, 0, At, B0); PG8_BAR; PG8_SCHED;
            PG8_STAGE(PG8_SB(1, 1), b3 + hstep, voffB);
            PG8_WAIT_V(6); PG8_BAR; PG8_MMA(1, 1, At, B1); PG8_BAR;
            }
        }
        if constexpr (ALIGN_EPI) { if (wr == 0) PG8_BAR; }
        if constexpr (!Epi::AFTER_DRAIN) { E(acc, cur, wr, wc, fr, fq); S.done(cur); }
        if (!has_next) break;
#pragma unroll
        for (int a = 0; a < 2; ++a)
#pragma unroll
            for (int b = 0; b < 2; ++b)
#pragma unroll
                for (int m = 0; m < 4; ++m)
#pragma unroll
                    for (int n = 0; n < 2; ++n) acc[a][b][m][n] = (f32x4){0.f, 0.f, 0.f, 0.f};
        cur = nxt; cA = nA; cB = nB; ++ui;
        if constexpr (ALIGN_EPI) { if (wr == 1) PG8_BAR; }
    }
    PG8_WAIT_V(0);
    if constexpr (!ALIGN_EPI) { if (wr == 0) PG8_BAR; }
    PG8_BAR;
    if constexpr (Epi::AFTER_DRAIN) { E.fused(acc, cur, wr, wc, fr, fq, lds, wid, lane); S.done(cur); }
#undef PG8_SA
#undef PG8_SB
#undef PG8_STAGE
#undef PG8_LDA
#undef PG8_LDB
#undef PG8_MMA
#undef PG8_WAIT_V
#undef PG8_WAIT_L
#undef PG8_BAR
#undef PG8_SCHED
}
}

#define DI __device__ __forceinline__
#define LAS __attribute__((address_space(3)))
#define GAS __attribute__((address_space(1)))
typedef unsigned short bf16;
typedef float f32x4 __attribute__((ext_vector_type(4)));
typedef float f32x16 __attribute__((ext_vector_type(16)));
typedef short bf16x8 __attribute__((ext_vector_type(8)));
typedef short s16x4 __attribute__((ext_vector_type(4)));
typedef unsigned u32x4 __attribute__((ext_vector_type(4)));
typedef unsigned u32x2 __attribute__((ext_vector_type(2)));

#ifndef PROBE
#define PROBE 0
#endif
#ifndef GEMM_ALIGN
#define GEMM_ALIGN true
#endif
#ifndef GEMM_SP2
#define GEMM_SP2 true
#endif
#ifndef MK_PER_PHASE
#define MK_PER_PHASE 0
#endif

constexpr int NWAVES = 8, NTHREADS = 512;
constexpr int BATCH = 16, SEQ = 2048, DM = 2048, M = BATCH * SEQ;
constexpr int NPHASE = 17;
constexpr size_t MiB = 1u << 20;
constexpr size_t WS_WA = 1 * MiB, WS_WB = 41 * MiB, WS_H = 105 * MiB, WS_P = 233 * MiB, WS_PS = 1001 * MiB, WS_END = 1017 * MiB;
constexpr int LDS_BYTES = 147456;

DI unsigned pk2(float lo, float hi) { return pg8::cvt_pk_bf16(lo, hi); }
DI float bflo(unsigned u) { return __uint_as_float(u << 16); }
DI float bfhi(unsigned u) { return __uint_as_float(u & 0xffff0000u); }
DI float bf2f(bf16 v) { return __uint_as_float(((unsigned)v) << 16); }
DI bf16 f2bf(float f) { return (bf16)(pk2(f, 0.f) & 0xffffu); }
DI float silu_f(float g) { return g * __builtin_amdgcn_rcpf(1.f + __expf(-g)); }
DI float wave_sum(float v) {
#pragma unroll
    for (int o = 1; o < 64; o <<= 1) v += __shfl_xor(v, o);
    return v;
}
DI int launder(int x) { asm volatile("" : "+v"(x)); return x; }
DI int crow(int i, int hh) { return (i & 3) + 8 * (i >> 2) + 4 * hh; }
#define LDS_WAIT() asm volatile("s_waitcnt lgkmcnt(0)" ::: "memory")
#define MFMA32(a, b, c) __builtin_amdgcn_mfma_f32_32x32x16_bf16((a), (b), (c), 0, 0, 0)

template <int S> DI bf16x8 pack_step(const f32x16& x) {
    u32x4 p;
    p.x = pk2(x[8 * S + 0], x[8 * S + 1]); p.y = pk2(x[8 * S + 2], x[8 * S + 3]);
    p.z = pk2(x[8 * S + 4], x[8 * S + 5]); p.w = pk2(x[8 * S + 6], x[8 * S + 7]);
    return __builtin_bit_cast(bf16x8, p);
}
DI bf16x8 tr_frag(const LAS unsigned char* img, int pitch, int row0, int row1, int colbyte, int q4) {
    const s16x4 lo = __builtin_amdgcn_ds_read_tr16_b64_v4i16((LAS s16x4*)(img + (row0 + q4) * pitch + colbyte));
    const s16x4 hi = __builtin_amdgcn_ds_read_tr16_b64_v4i16((LAS s16x4*)(img + (row1 + q4) * pitch + colbyte));
    return __builtin_shufflevector(lo, hi, 0, 1, 2, 3, 4, 5, 6, 7);
}

namespace pg8 {
struct EpiConvFused {
    static constexpr bool PERM = false, AFTER_DRAIN = false;
    bf16_t* Y; bf16_t* VB; bf16_t* BGB; const float* SS; const float* cw; const float* cb;
    template <int CTRL> static __device__ __forceinline__ float dppf(float f) { const int x = __builtin_bit_cast(int, f); return __builtin_bit_cast(float, __builtin_amdgcn_update_dpp(x, x, CTRL, 0xf, 0xf, false)); }
    template <int CTRL> static __device__ __forceinline__ f32x4 rorv(const f32x4 v) { f32x4 o; o.x = dppf<CTRL>(v.x); o.y = dppf<CTRL>(v.y); o.z = dppf<CTRL>(v.z); o.w = dppf<CTRL>(v.w); return o; }
    __device__ __forceinline__ void operator()(const f32x4 (&acc)[2][2][4][2], const Unit& u, int wr, int wc, int fr, int fq) const {
        typedef unsigned u2 __attribute__((ext_vector_type(2)));
        const int row0 = u.pm * BM + wr * 64 + fr, ch = u.pn * 64 + wc * 16 + fq * 4;
        float rsv[2][4];
#pragma unroll
        for (int ai = 0; ai < 2; ++ai)
#pragma unroll
            for (int m = 0; m < 4; ++m) rsv[ai][m] = SS ? SS[row0 + ai * HALF + m * 16] : 1.f;
        const f32x4 w0 = *(const f32x4*)(cw + ch), w1 = *(const f32x4*)(cw + 2048 + ch), w2 = *(const f32x4*)(cw + 4096 + ch), bb = *(const f32x4*)(cb + ch);
#pragma unroll
        for (int ai = 0; ai < 2; ++ai) {
            const int slab = u.pm * 4 + ai * 2 + wr;
            f32x4 vprev = {0.f, 0.f, 0.f, 0.f};
#pragma unroll
            for (int m = 0; m < 4; ++m) {
                const int row = row0 + ai * HALF + m * 16;
                const float rs = rsv[ai][m];
                const f32x4 b = acc[ai][0][m][0] * rs, c = acc[ai][0][m][1] * rs, uu = acc[ai][1][m][0] * rs, g = acc[ai][1][m][1] * rs;
                const f32x4 v = c * uu;
                f32x4 sg;
#pragma unroll
                for (int e = 0; e < 4; ++e) sg[e] = b[e] * g[e] * __builtin_amdgcn_rcpf(1.f + __expf(-g[e]));
                const f32x4 a1 = rorv<0x121>(v), a2 = rorv<0x122>(v), q1 = rorv<0x121>(vprev), q2 = rorv<0x122>(vprev);
                const f32x4 p1 = (fr == 0) ? q1 : a1, p2 = (fr < 2) ? q2 : a2;
                const f32x4 y = sg * (bb + w0 * p2 + w1 * p1 + w2 * v);
                u2 wy; wy.x = cvt_pk_bf16(y[0], y[1]); wy.y = cvt_pk_bf16(y[2], y[3]);
                u2 wv; wv.x = cvt_pk_bf16(v[0], v[1]); wv.y = cvt_pk_bf16(v[2], v[3]);
                if (m == 0) {
                    if (fr >= 2) __builtin_nontemporal_store(wy, (u2*)(Y + (size_t)row * 2048 + ch));
                    else { u2 ws; ws.x = cvt_pk_bf16(sg[0], sg[1]); ws.y = cvt_pk_bf16(sg[2], sg[3]);
                           *(u2*)(VB + ((size_t)slab * 4 + 2 + fr) * 2048 + ch) = wv; *(u2*)(BGB + ((size_t)slab * 2 + fr) * 2048 + ch) = ws; }
                } else {
                    __builtin_nontemporal_store(wy, (u2*)(Y + (size_t)row * 2048 + ch));
                    if (m == 3 && fr >= 14) *(u2*)(VB + ((size_t)slab * 4 + (fr - 14)) * 2048 + ch) = wv;
                }
                vprev = v;
            }
        }
    }
};
struct EpiResid {
    static constexpr bool PERM = true, AFTER_DRAIN = false;
    const bf16_t* base16; float* out32; bf16_t* XB; float* SS;
    __device__ __forceinline__ void operator()(const f32x4 (&acc)[2][2][4][2], const Unit& u, int wr, int wc, int fr, int fq) const {
        const int row0 = u.pm * BM + wr * 64 + fr, col0 = u.pn * BM + wc * 32 + 8 * fq;
#pragma unroll
        for (int ai = 0; ai < 2; ++ai) {
            u32x4 raw[4][2];
#pragma unroll
            for (int m = 0; m < 4; ++m)
#pragma unroll
                for (int bj = 0; bj < 2; ++bj) raw[m][bj] = *(const u32x4*)(base16 + (size_t)(row0 + ai * HALF + m * 16) * 2048 + col0 + bj * HALF);
#pragma unroll
            for (int m = 0; m < 4; ++m) {
                const int row = row0 + ai * HALF + m * 16;
                const size_t off = (size_t)row * 2048 + col0;
                float sq = 0.f;
#pragma unroll
                for (int bj = 0; bj < 2; ++bj) {
                    const u32x4 w = raw[m][bj];
                    const f32x4 r0 = {__uint_as_float(w.x << 16), __uint_as_float(w.x & 0xffff0000u), __uint_as_float(w.y << 16), __uint_as_float(w.y & 0xffff0000u)};
                    const f32x4 r1 = {__uint_as_float(w.z << 16), __uint_as_float(w.z & 0xffff0000u), __uint_as_float(w.w << 16), __uint_as_float(w.w & 0xffff0000u)};
                    const f32x4 v0 = r0 + acc[ai][bj][m][0], v1 = r1 + acc[ai][bj][m][1];
                    if (out32) { __builtin_nontemporal_store(v0, (f32x4*)(out32 + off + bj * HALF)); __builtin_nontemporal_store(v1, (f32x4*)(out32 + off + bj * HALF + 4)); }
                    if (XB) { u32x4 o; o.x = cvt_pk_bf16(v0[0], v0[1]); o.y = cvt_pk_bf16(v0[2], v0[3]); o.z = cvt_pk_bf16(v1[0], v1[1]); o.w = cvt_pk_bf16(v1[2], v1[3]);
                              __builtin_nontemporal_store(o, (u32x4*)(XB + off + bj * HALF));
                              sq += ((v0[0] * v0[0] + v0[1] * v0[1]) + (v0[2] * v0[2] + v0[3] * v0[3])) + ((v1[0] * v1[0] + v1[1] * v1[1]) + (v1[2] * v1[2] + v1[3] * v1[3])); }
                }
                if (XB) { sq += __shfl_xor(sq, 16); sq += __shfl_xor(sq, 32); if (fq == 0) SS[(size_t)row * 32 + u.pn * 4 + wc] = sq; }
            }
        }
    }
};
struct EpiSplitRet {
    static constexpr bool PERM = true, AFTER_DRAIN = false;
    bf16_t *Oq, *Ok, *Ov, *Og; const float* SS; const float* qg; const float* kg; __attribute__((address_space(3))) float* xl;
    __device__ __forceinline__ void operator()(const f32x4 (&acc)[2][2][4][2], const Unit& u, int wr, int wc, int fr, int fq) const {
        const int row0 = u.pm * BM + wr * 64 + fr;
        float rsv[2][4];
#pragma unroll
        for (int ai = 0; ai < 2; ++ai)
#pragma unroll
            for (int m = 0; m < 4; ++m) rsv[ai][m] = SS[row0 + ai * HALF + m * 16];
        if (u.pn >= 16) {
            bf16_t* base = (u.pn >= 32) ? Og : Ov; const int ct = (u.pn >= 32) ? u.pn - 32 : u.pn - 16;
            const int col0 = ct * BM + wc * 32 + 8 * fq;
#pragma unroll
            for (int ai = 0; ai < 2; ++ai)
#pragma unroll
                for (int m = 0; m < 4; ++m) {
                    bf16_t* rowp = base + (size_t)(row0 + ai * HALF + m * 16) * 4096 + col0; const float rs = rsv[ai][m];
#pragma unroll
                    for (int bj = 0; bj < 2; ++bj) {
                        const f32x4 v0 = acc[ai][bj][m][0] * rs, v1 = acc[ai][bj][m][1] * rs;
                        u32x4 w; w.x = cvt_pk_bf16(v0[0], v0[1]); w.y = cvt_pk_bf16(v0[2], v0[3]); w.z = cvt_pk_bf16(v1[0], v1[1]); w.w = cvt_pk_bf16(v1[2], v1[3]);
                        __builtin_nontemporal_store(w, (u32x4*)(rowp + bj * HALF));
                    }
                }
            return;
        }
        const bool isK = u.pn >= 8; const int h = u.pn & 7;
        bf16_t* base = isK ? Ok : Oq; const float* gn = isK ? kg : qg;
        const int d0 = wc * 32 + 8 * fq;
#pragma unroll
        for (int ai = 0; ai < 2; ++ai)
#pragma unroll
            for (int m = 0; m < 4; ++m) {
                float sq = 0.f;
#pragma unroll
                for (int bj = 0; bj < 2; ++bj)
#pragma unroll
                    for (int n = 0; n < 2; ++n) { const f32x4 v = acc[ai][bj][m][n]; sq += (v[0] * v[0] + v[1] * v[1]) + (v[2] * v[2] + v[3] * v[3]); }
                sq += __shfl_xor(sq, 16); sq += __shfl_xor(sq, 32);
                if (fq == 0) xl[(ai * HALF + wr * 64 + m * 16 + fr) * 4 + wc] = sq * rsv[ai][m] * rsv[ai][m];
            }
        asm volatile("s_waitcnt lgkmcnt(0)" ::: "memory"); __builtin_amdgcn_s_barrier(); asm volatile("" ::: "memory");
        const float l2g = log2f(1.f - exp2f(-5.f - (float)h));
        float invf[8], g1[8], g2[8];
#pragma unroll
        for (int j = 0; j < 8; ++j) { invf[j] = exp2f(-(float)(d0 + j) * (13.287712379549449f / 128.f)); g1[j] = gn[d0 + j]; g2[j] = gn[128 + d0 + j]; }
#pragma unroll
        for (int ai = 0; ai < 2; ++ai)
#pragma unroll
            for (int m = 0; m < 4; ++m) {
                const int rl = ai * HALF + wr * 64 + m * 16 + fr, row = u.pm * BM + rl, t = row & 2047;
                const f32x4 pp = *(const __attribute__((address_space(3))) f32x4*)(xl + rl * 4);
                const float ss = (pp[0] + pp[1]) + (pp[2] + pp[3]);
                const float dq = exp2f((float)((t & 63) + 1) * l2g);
                const float scl = rsqrtf(ss * (1.f / 256.f) + 1e-6f) * rsv[ai][m] * (isK ? 0.0625f / dq : dq);
                const float pos = (float)t;
                f32x4 o1[2], o2[2];
#pragma unroll
                for (int n = 0; n < 2; ++n)
#pragma unroll
                    for (int e = 0; e < 4; ++e) {
                        const int j = 4 * n + e;
                        float rev = (pos * invf[j]) * 0.15915494309189535f; rev = __builtin_amdgcn_fractf(rev);
                        const float sn = __builtin_amdgcn_sinf(rev), cs = __builtin_amdgcn_cosf(rev);
                        const float x1 = acc[ai][0][m][n][e] * g1[j], x2 = acc[ai][1][m][n][e] * g2[j];
                        o1[n][e] = (x1 * cs - x2 * sn) * scl; o2[n][e] = (x2 * cs + x1 * sn) * scl;
                    }
                bf16_t* rowp = base + (size_t)row * 2048 + h * 256 + d0;
                u32x4 w;
                w.x = cvt_pk_bf16(o1[0][0], o1[0][1]); w.y = cvt_pk_bf16(o1[0][2], o1[0][3]); w.z = cvt_pk_bf16(o1[1][0], o1[1][1]); w.w = cvt_pk_bf16(o1[1][2], o1[1][3]);
                __builtin_nontemporal_store(w, (u32x4*)(rowp));
                w.x = cvt_pk_bf16(o2[0][0], o2[0][1]); w.y = cvt_pk_bf16(o2[0][2], o2[0][3]); w.z = cvt_pk_bf16(o2[1][0], o2[1][1]); w.w = cvt_pk_bf16(o2[1][2], o2[1][3]);
                __builtin_nontemporal_store(w, (u32x4*)(rowp + HALF));
            }
        asm volatile("s_waitcnt lgkmcnt(0)" ::: "memory"); __builtin_amdgcn_s_barrier(); asm volatile("" ::: "memory");
    }
};
struct EpiSplitSb {
    static constexpr bool PERM = true, AFTER_DRAIN = false;
    bf16_t *Oq, *Ok, *Ov, *Og; const float* SS; const float* qg; const float* kg; __attribute__((address_space(3))) float* xl;
    __device__ __forceinline__ void operator()(const f32x4 (&acc)[2][2][4][2], const Unit& u, int wr, int wc, int fr, int fq) const {
        const int row0 = u.pm * BM + wr * 64 + fr;
        float rsv[2][4];
#pragma unroll
        for (int ai = 0; ai < 2; ++ai)
#pragma unroll
            for (int m = 0; m < 4; ++m) rsv[ai][m] = SS[row0 + ai * HALF + m * 16];
        const int sec = u.pn >> 3, ct = u.pn & 7;
        bf16_t* base = sec == 0 ? Oq : (sec == 1 ? Ok : (sec == 2 ? Ov : Og));
        const int col0 = ct * BM + wc * 32 + 8 * fq;
        if (sec >= 2) {
#pragma unroll
            for (int ai = 0; ai < 2; ++ai)
#pragma unroll
                for (int m = 0; m < 4; ++m) {
                    bf16_t* rowp = base + (size_t)(row0 + ai * HALF + m * 16) * 2048 + col0; const float rs = rsv[ai][m];
#pragma unroll
                    for (int bj = 0; bj < 2; ++bj) {
                        const f32x4 v0 = acc[ai][bj][m][0] * rs, v1 = acc[ai][bj][m][1] * rs;
                        u32x4 w; w.x = cvt_pk_bf16(v0[0], v0[1]); w.y = cvt_pk_bf16(v0[2], v0[3]); w.z = cvt_pk_bf16(v1[0], v1[1]); w.w = cvt_pk_bf16(v1[2], v1[3]);
                        __builtin_nontemporal_store(w, (u32x4*)(rowp + bj * HALF));
                    }
                }
            return;
        }
        const float* gn = sec ? kg : qg; const float post = sec ? 1.f : 0.12751743f;
#pragma unroll
        for (int ai = 0; ai < 2; ++ai)
#pragma unroll
            for (int m = 0; m < 4; ++m)
#pragma unroll
                for (int bj = 0; bj < 2; ++bj) {
                    const f32x4 a = acc[ai][bj][m][0], b = acc[ai][bj][m][1];
                    float sq = ((a[0] * a[0] + a[1] * a[1]) + (a[2] * a[2] + a[3] * a[3])) + ((b[0] * b[0] + b[1] * b[1]) + (b[2] * b[2] + b[3] * b[3]));
                    sq += __shfl_xor(sq, 16); sq += __shfl_xor(sq, 32);
                    if (fq == 0) xl[((ai * HALF + wr * 64 + m * 16 + fr) * 2 + bj) * 4 + wc] = sq;
                }
        asm volatile("s_waitcnt lgkmcnt(0)" ::: "memory"); __builtin_amdgcn_s_barrier(); asm volatile("" ::: "memory");
        const f32x4 ga = *(const f32x4*)(gn + wc * 32 + 8 * fq), gb = *(const f32x4*)(gn + wc * 32 + 8 * fq + 4);
#pragma unroll
        for (int ai = 0; ai < 2; ++ai)
#pragma unroll
            for (int m = 0; m < 4; ++m) {
                const int rl = ai * HALF + wr * 64 + m * 16 + fr; const float rs = rsv[ai][m];
                bf16_t* rowp = base + (size_t)(u.pm * BM + rl) * 2048 + col0;
#pragma unroll
                for (int bj = 0; bj < 2; ++bj) {
                    const f32x4 pp = *(const __attribute__((address_space(3))) f32x4*)(xl + (rl * 2 + bj) * 4);
                    const float ss = ((pp[0] + pp[1]) + (pp[2] + pp[3])) * rs * rs;
                    const float scl = rsqrtf(ss * (1.f / 128.f) + 1e-6f) * rs * post;
                    const f32x4 v0 = acc[ai][bj][m][0] * ga * scl, v1 = acc[ai][bj][m][1] * gb * scl;
                    u32x4 w; w.x = cvt_pk_bf16(v0[0], v0[1]); w.y = cvt_pk_bf16(v0[2], v0[3]); w.z = cvt_pk_bf16(v1[0], v1[1]); w.w = cvt_pk_bf16(v1[2], v1[3]);
                    __builtin_nontemporal_store(w, (u32x4*)(rowp + bj * HALF));
                }
            }
        asm volatile("s_waitcnt lgkmcnt(0)" ::: "memory"); __builtin_amdgcn_s_barrier(); asm volatile("" ::: "memory");
    }
};
}

DI int conv_perm(int s) {
    const int sec = s >> 11, ch = s & 2047;
    return 256 * (ch >> 6) + 128 * (sec >> 1) + 32 * ((ch >> 4) & 3) + 16 * (sec & 1) + 4 * ((ch >> 2) & 3) + (ch & 3);
}
template <bool CONVPERM>
DI void transpose_item(const float* W, const float* gain, int K, int N, bf16* WT, LAS float* scr, int item, int lane) {
    const int nblk = N / 32, kb = item / nblk, nb = item % nblk, k0 = 64 * kb, n0 = 32 * nb;
    float tv[32];
#pragma unroll
    for (int i = 0; i < 32; ++i) { const int kk = 2 * i + (lane >> 5); tv[i] = W[(size_t)(k0 + kk) * N + n0 + (lane & 31)]; }
#pragma unroll
    for (int i = 0; i < 32; ++i) { const int kk = 2 * i + (lane >> 5); scr[kk * 33 + (lane & 31)] = tv[i] * (gain ? gain[k0 + kk] : 1.f); }
    LDS_WAIT(); asm volatile("" ::: "memory");
    const int c = lane & 7;
#pragma unroll
    for (int j = 0; j < 4; ++j) {
        const int n = (lane >> 3) + 8 * j; const LAS float* s = scr + (8 * c) * 33 + n;
        u32x4 o; o.x = pk2(s[0 * 33], s[1 * 33]); o.y = pk2(s[2 * 33], s[3 * 33]); o.z = pk2(s[4 * 33], s[5 * 33]); o.w = pk2(s[6 * 33], s[7 * 33]);
        int nd = n0 + n; if (CONVPERM) nd = conv_perm(nd);
        *(u32x4*)(WT + (size_t)nd * K + k0 + 8 * c) = o;
    }
    LDS_WAIT(); asm volatile("" ::: "memory");
}
template <bool CONVPERM>
DI void transpose_all(const float* W, const float* gain, int K, int N, bf16* WT, LAS float* scr, int gw, int ngw, int lane_) {
    const int lane = launder(lane_);
    const int nitems = (K / 64) * (N / 32);
    for (int it = gw; it < nitems; it += ngw) transpose_item<CONVPERM>(W, gain, K, N, WT, scr, it, lane);
}
DI void x_to_bf16_rows(const float* x, bf16* h, float* RS, int gw, int ngw, int lane_) {
    const int lane = launder(lane_);
    for (int m = gw; m < M; m += ngw) {
        const f32x4* xr = (const f32x4*)(x + (size_t)m * DM) + lane;
        f32x4 v[8]; float s = 0.f;
#pragma unroll
        for (int j = 0; j < 8; ++j) { v[j] = xr[64 * j]; s += (v[j].x * v[j].x + v[j].y * v[j].y) + (v[j].z * v[j].z + v[j].w * v[j].w); }
        const float rs = rsqrtf(wave_sum(s) * (1.f / DM) + 1e-6f);
        u32x2* o = (u32x2*)(h + (size_t)m * DM) + lane;
#pragma unroll
        for (int j = 0; j < 8; ++j) { u32x2 w; w.x = pk2(v[j].x, v[j].y); w.y = pk2(v[j].z, v[j].w); o[64 * j] = w; }
        if (lane == 0) RS[m] = rs;
    }
}
DI void rs_phase(const float* PS, float* RS, int G, int blk) {
    for (int row = blk * NTHREADS + launder((int)threadIdx.x); row < M; row += G * NTHREADS) {
        const f32x4* p = (const f32x4*)(PS + (size_t)row * 32); float s = 0.f;
#pragma unroll
        for (int j = 0; j < 8; ++j) { const f32x4 v = p[j]; s += (v.x + v.y) + (v.z + v.w); }
        RS[row] = rsqrtf(s * (1.f / 2048.f) + 1e-6f);
    }
}
DI void conv_fix_phase(const bf16* VB, const bf16* BGB, bf16* Y, const float* cw, const float* cb, int G, int blk) {
    const int gtid = blk * NTHREADS + launder((int)threadIdx.x); const int stride = G * NTHREADS;
    const int ch = (gtid & 255) * 8;
    float w0[8], w1[8], w2[8], bb[8];
#pragma unroll
    for (int e = 0; e < 8; ++e) { w0[e] = cw[ch + e]; w1[e] = cw[2048 + ch + e]; w2[e] = cw[4096 + ch + e]; bb[e] = cb[ch + e]; }
    for (int idx = gtid; idx < (M / 64) * 2 * 256; idx += stride) {
        const int sj = idx >> 8, slab = sj >> 1, j = sj & 1;
        const bool first = (slab & 31) == 0;
        const u32x4 z = {0u, 0u, 0u, 0u};
        const u32x4 v0 = *(const u32x4*)(VB + ((size_t)slab * 4 + 2 + j) * 2048 + ch);
        const u32x4 v1 = j ? *(const u32x4*)(VB + ((size_t)slab * 4 + 2) * 2048 + ch) : (first ? z : *(const u32x4*)(VB + ((size_t)(slab - 1) * 4 + 1) * 2048 + ch));
        const u32x4 v2 = first ? z : *(const u32x4*)(VB + ((size_t)(slab - 1) * 4 + j) * 2048 + ch);
        const u32x4 bg = *(const u32x4*)(BGB + ((size_t)slab * 2 + j) * 2048 + ch);
        u32x4 o;
#pragma unroll
        for (int p = 0; p < 4; ++p) {
            const float c0 = bb[2 * p] + w0[2 * p] * bflo(v2[p]) + w1[2 * p] * bflo(v1[p]) + w2[2 * p] * bflo(v0[p]);
            const float c1 = bb[2 * p + 1] + w0[2 * p + 1] * bfhi(v2[p]) + w1[2 * p + 1] * bfhi(v1[p]) + w2[2 * p + 1] * bfhi(v0[p]);
            o[p] = pk2(bflo(bg[p]) * c0, bfhi(bg[p]) * c1);
        }
        *(u32x4*)(Y + ((size_t)slab * 64 + j) * 2048 + ch) = o;
    }
}

template <bool DRY>
DI void gn_phase(bf16* O, const bf16* Gt, const float* gw_, const float* gb_, int gw, int ngw, int lane_) {
    const int lane = launder(lane_);
    const int hd = gw & 7; const int c0 = hd * 512 + 8 * lane;
    float w[8], b[8];
#pragma unroll
    for (int e = 0; e < 8; ++e) { w[e] = gw_[c0 + e]; b[e] = gb_[c0 + e]; }
    for (int idx = gw; idx < M * 8; idx += ngw) {
        const size_t off = (size_t)(idx >> 3) * 4096 + c0;
        const u32x4 ov = *(const u32x4*)(O + off), gv = *(const u32x4*)(Gt + off);
        float x[8], g[8];
#pragma unroll
        for (int p = 0; p < 4; ++p) { x[2 * p] = bflo(ov[p]); x[2 * p + 1] = bfhi(ov[p]); g[2 * p] = bflo(gv[p]); g[2 * p + 1] = bfhi(gv[p]); }
        float s = 0.f;
#pragma unroll
        for (int e = 0; e < 8; ++e) s += x[e];
        const float mu = wave_sum(s) * (1.f / 512.f);
        float q = 0.f;
#pragma unroll
        for (int e = 0; e < 8; ++e) { x[e] -= mu; q += x[e] * x[e]; }
        const float rstd = rsqrtf(wave_sum(q) * (1.f / 512.f) + 1e-5f);
        u32x4 o;
#pragma unroll
        for (int p = 0; p < 4; ++p) {
            const float y0 = silu_f(g[2 * p]) * (x[2 * p] * rstd * w[2 * p] + b[2 * p]);
            const float y1 = silu_f(g[2 * p + 1]) * (x[2 * p + 1] * rstd * w[2 * p + 1] + b[2 * p + 1]);
            o[p] = pk2(y0, y1);
        }
        if (!DRY || rstd < 0.f) __builtin_nontemporal_store(o, (u32x4*)(O + off));
    }
}

template <bool DRY>
DI void ret_phase(LAS unsigned char* lds, const bf16* Q, const bf16* Kb, bf16* V, const float* qg, const float* kg, int G, int blk) {
    const int tid = launder((int)threadIdx.x), lane = tid & 63, wid = __builtin_amdgcn_readfirstlane(tid >> 6);
    const int r = lane & 31, hh = lane >> 5, q4 = (lane & 15) >> 2, p4 = lane & 3, blk16 = (lane >> 4) & 1;
    const int c = wid & 3, dh = wid >> 2;
    constexpr int QP = 528, KQP = 576, VP = 320, PP = 144;
    constexpr int OFF_Q = 0, OFF_K = 64 * QP, OFF_V = 64 * QP + 64 * KQP, OFF_P = OFF_V + 64 * VP, OFF_R = OFF_P + 64 * PP;
    static_assert(OFF_R + 32768 <= LDS_BYTES - 64, "retention LDS map");
    const LAS unsigned char* Qi = lds + OFF_Q; const LAS unsigned char* Ki = lds + OFF_K; const LAS unsigned char* Vi = lds + OFF_V; const LAS unsigned char* Pi = lds + OFF_P;
    LAS float* Red = (LAS float*)(lds + OFF_R);
    const int srow = tid >> 4, sp = tid & 15, vr = tid >> 3, vp = tid & 7;
    u32x4 rq[4], rk[4], rv[2];
#define RET_LOAD(n_) do { _Pragma("unroll") for (int jj = 0; jj < 2; ++jj) { const size_t m_ = (size_t)b * SEQ + (n_) * 64 + srow + 32 * jj; \
            const bf16* qp_ = Q + m_ * 2048 + h * 256 + 8 * sp; const bf16* kp_ = Kb + m_ * 2048 + h * 256 + 8 * sp; \
            rq[2 * jj] = *(const u32x4*)qp_; rq[2 * jj + 1] = *(const u32x4*)(qp_ + 128); rk[2 * jj] = *(const u32x4*)kp_; rk[2 * jj + 1] = *(const u32x4*)(kp_ + 128); } \
        const bf16* vp_ = V + ((size_t)b * SEQ + (n_) * 64 + vr) * 4096 + h * 512 + vs * 128 + 8 * vp; rv[0] = *(const u32x4*)vp_; rv[1] = *(const u32x4*)(vp_ + 64); } while (0)
#define RET_STAGE() do { _Pragma("unroll") for (int jj = 0; jj < 2; ++jj) { const int row_ = srow + 32 * jj; \
            *(LAS u32x4*)(lds + OFF_Q + row_ * QP + 16 * sp) = rq[2 * jj]; *(LAS u32x4*)(lds + OFF_Q + row_ * QP + 256 + 16 * sp) = rq[2 * jj + 1]; \
            *(LAS u32x4*)(lds + OFF_K + row_ * KQP + 16 * sp) = rk[2 * jj]; *(LAS u32x4*)(lds + OFF_K + row_ * KQP + 256 + 16 * sp) = rk[2 * jj + 1]; } \
        *(LAS u32x4*)(lds + OFF_V + vr * VP + 16 * vp) = rv[0]; *(LAS u32x4*)(lds + OFF_V + vr * VP + 128 + 16 * vp) = rv[1]; } while (0)
    for (int it = blk; it < 512; it += G) {
        const int loc = it & 255, rnd = it >> 8;
        const int vs = (loc >> 3) & 3, bh = rnd * 64 + (loc & 7) * 8 + (loc >> 5);
        const int b = bh >> 3, h = bh & 7;
        const float gam = 1.f - exp2f(-5.f - (float)h), l2g = log2f(gam), gC = exp2f(64.f * l2g);
        f32x16 st[4];
#pragma unroll
        for (int d = 0; d < 4; ++d)
#pragma unroll
            for (int i = 0; i < 16; ++i) st[d][i] = 0.f;
        RET_LOAD(0);
        for (int n = 0; n < 32; ++n) {
            const int t0 = n * 64;
            RET_STAGE();
            __syncthreads();
            if (n < 31) RET_LOAD(n + 1);
            if (wid < 3) {
                const int kt = (wid == 2) ? 1 : 0, qt = (wid >= 1) ? 1 : 0;
                f32x16 X;
#pragma unroll
                for (int i = 0; i < 16; ++i) X[i] = 0.f;
                const LAS unsigned char* ka = Ki + (32 * kt + r) * KQP + 16 * hh; const LAS unsigned char* qa = Qi + (32 * qt + r) * QP + 16 * hh;
#pragma unroll
                for (int s4 = 0; s4 < 4; ++s4) {
                    bf16x8 Af[4], Bf[4];
#pragma unroll
                    for (int s = 0; s < 4; ++s) { Af[s] = *(const LAS bf16x8*)(ka + 32 * (4 * s4 + s)); Bf[s] = *(const LAS bf16x8*)(qa + 32 * (4 * s4 + s)); }
                    __builtin_amdgcn_sched_barrier(0);
#pragma unroll
                    for (int s = 0; s < 4; ++s) X = MFMA32(Af[s], Bf[s], X);
                }
                if (kt == qt) {
#pragma unroll
                    for (int i = 0; i < 16; ++i) if (crow(i, hh) > r) X[i] = 0.f;
                }
#pragma unroll
                for (int g = 0; g < 4; ++g) { u32x2 w; w.x = pk2(X[4 * g], X[4 * g + 1]); w.y = pk2(X[4 * g + 2], X[4 * g + 3]);
                    *(LAS u32x2*)(lds + OFF_P + (32 * qt + r) * PP + 2 * (32 * kt + 8 * g + 4 * hh)) = w; }
            }
            f32x16 Op[2];
#pragma unroll
            for (int i = 0; i < 16; ++i) { Op[0][i] = 0.f; Op[1][i] = 0.f; }
#pragma unroll
            for (int dt = 0; dt < 4; ++dt) {
                const bf16x8 B0 = pack_step<0>(st[dt]), B1 = pack_step<1>(st[dt]);
                s16x4 qf[2][4];
#pragma unroll
                for (int qt = 0; qt < 2; ++qt) {
                    const LAS unsigned char* qa = Qi + (32 * qt + r) * QP + 2 * (128 * dh + 32 * dt + 4 * hh);
                    qf[qt][0] = *(const LAS s16x4*)(qa); qf[qt][1] = *(const LAS s16x4*)(qa + 16); qf[qt][2] = *(const LAS s16x4*)(qa + 32); qf[qt][3] = *(const LAS s16x4*)(qa + 48);
                }
                __builtin_amdgcn_sched_barrier(0);
#pragma unroll
                for (int qt = 0; qt < 2; ++qt) {
                    Op[qt] = MFMA32(__builtin_shufflevector(qf[qt][0], qf[qt][1], 0, 1, 2, 3, 4, 5, 6, 7), B0, Op[qt]);
                    Op[qt] = MFMA32(__builtin_shufflevector(qf[qt][2], qf[qt][3], 0, 1, 2, 3, 4, 5, 6, 7), B1, Op[qt]);
                }
            }
            __syncthreads();
#pragma unroll
            for (int qt = 0; qt < 2; ++qt) {
                if (dh <= qt) {
#pragma unroll
                    for (int s = 0; s < 2; ++s) {
                        const bf16x8 A = *(const LAS bf16x8*)(Pi + (32 * qt + r) * PP + 2 * (32 * dh + 16 * s + 8 * hh));
                        const int rb = 32 * dh + 16 * s + 8 * hh;
                        const bf16x8 B = tr_frag(Vi, VP, rb, rb + 4, 2 * (32 * c + 16 * blk16 + 4 * p4), q4);
                        Op[qt] = MFMA32(A, B, Op[qt]);
                    }
                }
            }
            {
                bf16x8 Bv[4];
#pragma unroll
                for (int s = 0; s < 4; ++s) { const int rb = 16 * s + 8 * hh; Bv[s] = tr_frag(Vi, VP, rb, rb + 4, 2 * (32 * c + 16 * blk16 + 4 * p4), q4); }
#pragma unroll
                for (int dt = 0; dt < 4; ++dt) {
                    bf16x8 Ak[4];
#pragma unroll
                    for (int s = 0; s < 4; ++s) { const int rb = 16 * s + 8 * hh; Ak[s] = tr_frag(Ki, KQP, rb, rb + 4, 2 * (128 * dh + 32 * dt + 16 * blk16 + 4 * p4), q4); }
                    __builtin_amdgcn_sched_barrier(0);
#pragma unroll
                    for (int s = 0; s < 4; ++s) st[dt] = MFMA32(Ak[s], Bv[s], st[dt]);
#pragma unroll
                    for (int i = 0; i < 16; ++i) st[dt][i] *= gC;
                }
            }
            if (dh == 1) {
#pragma unroll
                for (int qt = 0; qt < 2; ++qt)
#pragma unroll
                    for (int i = 0; i < 16; ++i) Red[c * 2048 + (32 * qt + crow(i, hh)) * 32 + r] = Op[qt][i];
            }
            __syncthreads();
            if (dh == 0 && (!DRY || gC > 2.f)) {
#pragma unroll
                for (int qt = 0; qt < 2; ++qt)
#pragma unroll
                    for (int i = 0; i < 16; ++i) {
                        const int q = 32 * qt + crow(i, hh);
                        const float v = Op[qt][i] + Red[c * 2048 + q * 32 + r];
                        V[((size_t)b * SEQ + t0 + q) * 4096 + h * 512 + vs * 128 + 32 * c + r] = f2bf(v);
                    }
            }
        }
    }
}

#undef RET_LOAD
#undef RET_STAGE
DI void sb_phase(LAS unsigned char* lds, const bf16* Q, const bf16* Kb, const bf16* Vb, const bf16* Gb, bf16* Y, const float* qg, const float* kg, int G, int blk) {
    const int tid = launder((int)threadIdx.x), lane = tid & 63, wid = __builtin_amdgcn_readfirstlane(tid >> 6);
    const int r = lane & 31, hh = lane >> 5, q4 = (lane & 15) >> 2, p4 = lane & 3, blk16 = (lane >> 4) & 1;
    volatile LAS unsigned* alive = (volatile LAS unsigned*)(lds + LDS_BYTES - 64) + 4;
    constexpr int KP = 272, TB = 64 * KP, VPs = 320, TBV = 64 * VPs;
    const int kr = tid >> 3, kp8 = tid & 7;
    for (int bh = blk; bh < 256; bh += G) {
        u32x4 pk1, pk2_, pv1, pv2;
        bf16x8 Qf[8];
        for (int qb = 7; qb >= 0; --qb) {
            const int b = bh >> 4, h = bh & 15, q0 = 256 * qb;
            const int r_l = launder(r), hh_l = launder(hh), lane_l = launder(lane);
            if (qb == 7) {
                const bf16* qp = Q + ((size_t)b * SEQ + q0 + 32 * wid + r_l) * 2048 + h * 128 + 8 * hh_l;
#pragma unroll
                for (int s = 0; s < 8; ++s) Qf[s] = *(const bf16x8*)(qp + 16 * s);
            }
            f32x16 O[4];
#pragma unroll
            for (int d = 0; d < 4; ++d)
#pragma unroll
                for (int i = 0; i < 16; ++i) O[d][i] = 0.f;
            float R = 1.f;
            const int ktmax = 4 * qb + 3, stmax = 8 * qb + wid;
#define SB_LOAD(kt_) do { const size_t m_ = (size_t)b * SEQ + 64 * (kt_) + kr; const bf16* kp_ = Kb + m_ * 2048 + h * 128 + 8 * kp8; const bf16* vp_ = Vb + m_ * 2048 + h * 128 + 8 * kp8; \
        pk1 = *(const u32x4*)kp_; pk2_ = *(const u32x4*)(kp_ + 64); pv1 = *(const u32x4*)vp_; pv2 = *(const u32x4*)(vp_ + 64); } while (0)
#define SB_STORE(buf_) do { LAS unsigned char* kb_ = lds + (buf_) * TB + kr * KP + 16 * kp8; LAS unsigned char* vb_ = lds + 2 * TB + (buf_) * TBV + kr * VPs + 16 * kp8; \
        *(LAS u32x4*)kb_ = pk1; *(LAS u32x4*)(kb_ + 128) = pk2_; *(LAS u32x4*)vb_ = pv1; *(LAS u32x4*)(vb_ + 128) = pv2; } while (0)
            if (qb == 7) SB_LOAD(ktmax);
            SB_STORE(0);
            if (tid < 3) alive[tid] = 0u;
            __syncthreads();
            int cur = 0;
            bool wdone = false;
            for (int kt = ktmax; kt >= 0; --kt) {
                if (kt < ktmax && alive[(kt + 1) % 3] == 0u) break;
                if (tid == 0) alive[(kt + 2) % 3] = 0u;
                if (kt > 0) SB_LOAD(kt - 1);
                const LAS unsigned char* Kimg = lds + cur * TB; const LAS unsigned char* Vimg = lds + 2 * TB + cur * TBV;
#define SB_SUBTILE(ss_) do { \
                        bf16x8 Kf[8]; \
                        { const LAS unsigned char* ka = Kimg + (32 * (ss_) + r) * KP + 16 * hh; \
                          _Pragma("unroll") for (int s = 0; s < 8; ++s) Kf[s] = *(const LAS bf16x8*)(ka + 32 * s); } \
                        __builtin_amdgcn_sched_barrier(0); \
                        f32x16 X; \
                        _Pragma("unroll") for (int i = 0; i < 16; ++i) X[i] = 0.f; \
                        _Pragma("unroll") for (int s = 0; s < 8; ++s) X = MFMA32(Kf[s], Qf[s], X); \
                        if (2 * kt + (ss_) == stmax) {     \
                            _Pragma("unroll") for (int i = 0; i < 16; ++i) if (crow(i, hh) >= r) X[i] = -1e30f; } \
                        bf16x8 Vf[8]; \
                        _Pragma("unroll") for (int dvt = 0; dvt < 4; ++dvt) { const int cb = 2 * (32 * dvt + 16 * blk16 + 4 * p4); \
                            Vf[2 * dvt] = tr_frag(Vimg, VPs, 32 * (ss_) + 4 * hh, 32 * (ss_) + 8 + 4 * hh, cb, q4); \
                            Vf[2 * dvt + 1] = tr_frag(Vimg, VPs, 32 * (ss_) + 16 + 4 * hh, 32 * (ss_) + 24 + 4 * hh, cb, q4); } \
                        __builtin_amdgcn_sched_barrier(0); \
                          \
                        float lf[16]; \
                        _Pragma("unroll") for (int i = 0; i < 16; ++i) { const float e = __builtin_amdgcn_exp2f(X[i]); X[i] = e; lf[i] = __builtin_amdgcn_rcpf(1.f + e); } \
                        float gs[4], ot[4], off[4]; \
                        _Pragma("unroll") for (int g = 0; g < 4; ++g) { lf[4 * g + 2] *= lf[4 * g + 3]; lf[4 * g + 1] *= lf[4 * g + 2]; lf[4 * g] *= lf[4 * g + 1]; gs[g] = lf[4 * g]; } \
                        _Pragma("unroll") for (int g = 0; g < 4; ++g) { const unsigned gi = __builtin_bit_cast(unsigned, gs[g]); \
                            const auto sw = __builtin_amdgcn_permlane32_swap(gi, gi, false, false); ot[g] = __builtin_bit_cast(float, hh ? sw[0] : sw[1]); } \
                        float hi_ = R; \
                        _Pragma("unroll") for (int g = 3; g >= 0; --g) { off[g] = hi_ * (hh == 0 ? ot[g] : 1.f); hi_ *= gs[g] * ot[g]; } \
                        _Pragma("unroll") for (int i = 0; i < 16; ++i) X[i] = X[i] * (off[i >> 2] * lf[i]); \
                        R = hi_; \
                        const bf16x8 A0 = pack_step<0>(X), A1 = pack_step<1>(X); \
                        _Pragma("unroll") for (int dvt = 0; dvt < 4; ++dvt) { O[dvt] = MFMA32(A0, Vf[2 * dvt], O[dvt]); O[dvt] = MFMA32(A1, Vf[2 * dvt + 1], O[dvt]); } \
                    } while (0)
                if (2 * kt + 1 <= stmax && !wdone) SB_SUBTILE(1);
                if (2 * kt <= stmax && !wdone) { SB_SUBTILE(0); wdone = (__builtin_amdgcn_ballot_w64(R != 0.f) == 0ull); }
                if (!wdone && lane == 0) alive[kt % 3] = 1u;
#undef SB_SUBTILE
                if (kt > 0) SB_STORE(cur ^ 1);
                __syncthreads();
                cur ^= 1;
            }
            if (qb > 0) {
                SB_LOAD(4 * (qb - 1) + 3);
                const bf16* qp = Q + ((size_t)b * SEQ + q0 - 256 + 32 * wid + r_l) * 2048 + h * 128 + 8 * hh_l;
#pragma unroll
                for (int s = 0; s < 8; ++s) Qf[s] = *(const bf16x8*)(qp + 16 * s);
            }
#undef SB_LOAD
#undef SB_STORE
            {
                LAS unsigned char* Ow = lds + 2 * TB + 2 * TBV + wid * (32 * KP);
                const int pc = lane_l & 15, rw = lane_l >> 4;
                const bf16* gp = Gb + ((size_t)b * SEQ + q0 + 32 * wid + rw) * 2048 + h * 128 + 8 * pc;
                bf16* yp = Y + ((size_t)b * SEQ + q0 + 32 * wid + rw) * 2048 + h * 128 + 8 * pc;
                u32x4 gv[8];
#pragma unroll
                for (int j = 0; j < 8; ++j) gv[j] = *(const u32x4*)(gp + (size_t)j * 4 * 2048);
#pragma unroll
                for (int dvt = 0; dvt < 4; ++dvt)
#pragma unroll
                    for (int i = 0; i < 16; ++i) *(LAS bf16*)(Ow + crow(i, hh) * KP + 2 * (32 * dvt + r)) = f2bf(O[dvt][i]);
                LDS_WAIT(); asm volatile("" ::: "memory");
#pragma unroll
                for (int j = 0; j < 8; ++j) {
                    const u32x4 ov = *(const LAS u32x4*)(Ow + (rw + 4 * j) * KP + 16 * pc);
                    u32x4 yo;
#pragma unroll
                    for (int p = 0; p < 4; ++p) yo[p] = pk2(silu_f(bflo(gv[j][p])) * bflo(ov[p]), silu_f(bfhi(gv[j][p])) * bfhi(ov[p]));
                    __builtin_nontemporal_store(yo, (u32x4*)(yp + (size_t)j * 4 * 2048));
                }
                LDS_WAIT(); asm volatile("" ::: "memory");
            }
        }
    }
}

#define XB_TMO      128
#define XB_XCNT(j)  (256  + 64 * (j))
#define XB_XSUB(j)  (1280 + 64 * (j))
#define XB_XGEN(j)  (2304 + 64 * (j))
#define XB_TOP      3328
#define XB_TOPGEN   3392
#define XCD_BAR_WORDS 3456
#define XB_SPIN_CAP (1u << 18)

__device__ __forceinline__ unsigned xb_ld(unsigned* p)              { return __hip_atomic_load(p, __ATOMIC_RELAXED, __HIP_MEMORY_SCOPE_AGENT); }
__device__ __forceinline__ unsigned xb_add(unsigned* p, unsigned v) { return __hip_atomic_fetch_add(p, v, __ATOMIC_RELAXED, __HIP_MEMORY_SCOPE_AGENT); }
__device__ __forceinline__ unsigned xb_xcc_id() { return (unsigned)__builtin_amdgcn_s_getreg((3 << 11) | 20) & 0xFu; }
#define XB_SPIN(cond, bar) do { unsigned _sp = 0; while (cond) { __builtin_amdgcn_s_sleep(1); \
    if ((++_sp & 255u) == 0u) { if (xb_ld(&(bar)[XB_TMO])) break; if (_sp > XB_SPIN_CAP) { atomicAdd(&(bar)[XB_TMO], 1u); break; } } } } while (0)

struct XcdBarrier {
    unsigned* bar; unsigned x;
    volatile LAS unsigned* st;
};

__device__ __forceinline__ XcdBarrier xcd_barrier_post(unsigned* bar, volatile LAS unsigned* st) {
    XcdBarrier b; b.bar = bar; b.x = xb_xcc_id(); b.st = st;
    if (threadIdx.x == 0) (void)xb_add(&bar[XB_XCNT(b.x)], 1u);
    return b;
}
__device__ __forceinline__ void xcd_barrier_complete(unsigned* bar, unsigned x, unsigned& nloc, unsigned& nx) {
    const unsigned G = gridDim.x * gridDim.y * gridDim.z;
    unsigned sum, cnt, mine, sp = 0u;
    for (;;) {
        sum = 0u; cnt = 0u; mine = 0u;
#pragma unroll
        for (unsigned j = 0; j < 16; ++j) { const unsigned c = xb_ld(&bar[XB_XCNT(j)]); sum += c; cnt += (c > 0u) ? 1u : 0u; mine = (j == x) ? c : mine; }
        if (sum == G) break;
        __builtin_amdgcn_s_sleep(1);
        if ((++sp & 255u) == 0u) { if (xb_ld(&bar[XB_TMO])) break; if (sp > XB_SPIN_CAP) { atomicAdd(&bar[XB_TMO], 1u); break; } }
    }
    nloc = mine > 0u ? mine : 1u; nx = cnt > 0u ? cnt : 1u;
}

__device__ __forceinline__ void xcd_barrier(const XcdBarrier& b) {
    asm volatile("s_waitcnt vmcnt(0)" ::: "memory");
    __syncthreads();
    if (threadIdx.x == 0) {
        unsigned* bar = b.bar;
        __builtin_amdgcn_s_waitcnt(0);
        unsigned nloc = b.st[0], nx = b.st[1];
        if (nloc == 0u) { xcd_barrier_complete(bar, b.x, nloc, nx); b.st[0] = nloc; b.st[1] = nx; }
        const unsigned old = xb_add(&bar[XB_XSUB(b.x)], 1u);
        const unsigned gen = old / nloc;
        if (old + 1u == (gen + 1u) * nloc) {
            __builtin_amdgcn_fence(__ATOMIC_RELEASE, "agent");
            asm volatile("s_waitcnt vmcnt(0)" ::: "memory");
            const unsigned og = xb_add(&bar[XB_TOP], 1u);
            const unsigned tg = og / nx;
            if (og + 1u == (tg + 1u) * nx) xb_add(&bar[XB_TOPGEN], 1u);
            else XB_SPIN(xb_ld(&bar[XB_TOPGEN]) == tg, bar);
            __builtin_amdgcn_fence(__ATOMIC_ACQUIRE, "agent");
            xb_add(&bar[XB_XGEN(b.x)], 1u);
            asm volatile("s_waitcnt vmcnt(0)" ::: "memory");
        } else {
            XB_SPIN(xb_ld(&bar[XB_XGEN(b.x)]) == gen, bar);
            __builtin_amdgcn_fence(__ATOMIC_ACQUIRE, "agent");
            asm volatile("s_waitcnt vmcnt(0)" ::: "memory");
        }
    }
    __syncthreads();
}

struct ProbeOrder : pg8::StaticOrder {
    int reps;
    __device__ bool next(int i, pg8::Unit& u) const { const int cnt = (nwg - c + G - 1) / G; if (i >= reps * cnt) return false; return pg8::StaticOrder::next(i % cnt, u); }
};
struct Args { const float* in[18]; float* out; unsigned char* ws; int ph_lo, ph_hi; };
__global__ void __launch_bounds__(NTHREADS, 2) hybrid_fwd(Args args) {
    extern __shared__ __attribute__((aligned(16))) unsigned char lds_raw[];
    LAS unsigned char* lds = (LAS unsigned char*)lds_raw;
    const int tid = threadIdx.x, lane = tid & 63, wave = __builtin_amdgcn_readfirstlane(tid >> 6);
    const int G = gridDim.x, blk = blockIdx.x;
    const int gw = blk * NWAVES + wave, ngw = G * NWAVES;
    unsigned char* ws = args.ws;
    const float* x_in = args.in[0];
    float* xo = args.out;
    bf16* WA_in = (bf16*)(ws + WS_WA); bf16* WA_out = (bf16*)(ws + WS_WA + 32 * MiB);
    bf16* WB_in = (bf16*)(ws + WS_WB); bf16* WB_out_ret = (bf16*)(ws + WS_WB + 48 * MiB); bf16* WB_out_conv = (bf16*)(ws + WS_WB + 32 * MiB);
    bf16* H = (bf16*)(ws + WS_H);
    bf16* P0 = (bf16*)(ws + WS_P); bf16* P1 = (bf16*)(ws + WS_P + 128 * MiB); bf16* P2 = (bf16*)(ws + WS_P + 256 * MiB);
    bf16* P3 = (bf16*)(ws + WS_P + 384 * MiB); bf16* P4 = (bf16*)(ws + WS_P + 512 * MiB);
    LAS float* scr = (LAS float*)(lds + wave * 16384);
    const int lo = args.ph_lo, hi = args.ph_hi;
    volatile LAS unsigned* misc = (volatile LAS unsigned*)(lds + LDS_BYTES - 64);
    if (tid < 16) misc[tid] = 0u;
    __syncthreads();
    XcdBarrier bar; bar.bar = (unsigned*)ws; bar.x = 0; bar.st = nullptr;
    if (!MK_PER_PHASE) bar = xcd_barrier_post((unsigned*)ws, misc);
#define IN(k) (lo <= (k) && (k) < hi)
#define SEAM(k) do { if (IN(k) && IN((k) + 1)) { if ((k) == 0) cg::this_grid().sync(); else xcd_barrier(bar); } } while (0)
#define GEMM_PHASE(EPI, Aptr, Bptr, N_, K_, ...) do { pg8::Gemm g{(const pg8::bf16_t*)(Aptr), (const pg8::bf16_t*)(Bptr), M, (N_), (K_)}; pg8::StaticOrder S; S.init(M, (N_), G, blk); \
        pg8::EPI E{__VA_ARGS__}; pg8::gemm_phase<pg8::EPI, pg8::StaticOrder, GEMM_ALIGN, GEMM_SP2>(lds, g, S, E); } while (0)

#define GEMM_PHASE_P(EPI, Aptr, Bptr, N_, K_, ...) do { pg8::Gemm g{(const pg8::bf16_t*)(Aptr), (const pg8::bf16_t*)(Bptr), M, (N_), (K_)}; ProbeOrder S; S.init(M, (N_), G, blk); S.reps = ((PROBE == 1 || (PROBE == 5 && (K_) == 2048 && (N_) == 2048)) ? 2 : 1); \
        pg8::EPI E{__VA_ARGS__}; pg8::gemm_phase<pg8::EPI, ProbeOrder, GEMM_ALIGN, GEMM_SP2>(lds, g, S, E); } while (0)
    float* RS = (float*)(ws + 65536); float* PS = (float*)(ws + WS_PS); bf16* VBH = (bf16*)(ws + WS_PS + 4 * MiB); bf16* BGH = (bf16*)(ws + WS_PS + 12 * MiB);
    if (IN(0)) for (int rep = 0; rep < (PROBE == 4 ? 2 : 1); ++rep) {
        if (wave & 1) x_to_bf16_rows(x_in, H, RS, gw, ngw, lane);
        transpose_all<true>(args.in[2], args.in[1], 2048, 8192, WA_in, scr, gw, ngw, lane);
        transpose_all<false>(args.in[5], nullptr, 2048, 2048, WA_out, scr, gw, ngw, lane);
        transpose_all<false>(args.in[7], args.in[6], 2048, 12288, WB_in, scr, gw, ngw, lane);
        transpose_all<false>(args.in[12], nullptr, 4096, 2048, WB_out_ret, scr, gw, ngw, lane);
        if (!(wave & 1)) x_to_bf16_rows(x_in, H, RS, gw, ngw, lane);
    }
    SEAM(0);
    if (IN(1)) GEMM_PHASE_P(EpiConvFused, H, WA_in, 8192, 2048, P2, VBH, BGH, RS, args.in[3], args.in[4]);
    SEAM(1);
    if (IN(2)) { if (PROBE == 10) for (int q = 0; q < 20; ++q) xcd_barrier(bar); conv_fix_phase(VBH, BGH, P2, args.in[3], args.in[4], G, blk); }
    SEAM(2);
    if (IN(3)) { if (PROBE == 5) GEMM_PHASE_P(EpiResid, P2, WA_out, 2048, 2048, H, nullptr, H, PS); else GEMM_PHASE(EpiResid, P2, WA_out, 2048, 2048, H, nullptr, H, PS); }
    SEAM(3);
    if (IN(4)) rs_phase(PS, RS, G, blk);
    SEAM(4);
    if (IN(5)) GEMM_PHASE_P(EpiSplitRet, H, WB_in, 12288, 2048, P0, P1, P2, P4, RS, args.in[8], args.in[9], (LAS float*)(lds + 131072));
    SEAM(5);
    if (IN(6)) { if (PROBE == 2) { ret_phase<true>(lds, P0, P1, P2, args.in[8], args.in[9], G, blk); __syncthreads(); } ret_phase<false>(lds, P0, P1, P2, args.in[8], args.in[9], G, blk); }
    SEAM(6);
    if (IN(7)) {
        if (PROBE == 2) gn_phase<true>(P2, P4, args.in[10], args.in[11], gw, ngw, lane);
        gn_phase<false>(P2, P4, args.in[10], args.in[11], gw, ngw, lane);
        transpose_all<false>(args.in[14], args.in[13], 2048, 8192, WA_in, scr, gw, ngw, lane);
        transpose_all<false>(args.in[17], nullptr, 2048, 2048, WA_out, scr, gw, ngw, lane);
    }
    SEAM(7);
    if (IN(8)) GEMM_PHASE(EpiResid, P2, WB_out_ret, 2048, 4096, H, nullptr, H, PS);
    SEAM(8);
    if (IN(9)) rs_phase(PS, RS, G, blk);
    SEAM(9);
    if (IN(10)) GEMM_PHASE_P(EpiSplitSb, H, WA_in, 8192, 2048, P0, P1, P2, P3, RS, args.in[15], args.in[16], (LAS float*)(lds + 131072));
    SEAM(10);
    if (IN(11)) {
        transpose_all<true>(args.in[2] + (size_t)2048 * 8192, args.in[1] + 2048, 2048, 8192, WB_in, scr, gw, ngw, lane);
        transpose_all<false>(args.in[5] + (size_t)2048 * 2048, nullptr, 2048, 2048, WB_out_conv, scr, gw, ngw, lane);
        for (int rep = 0; rep < (PROBE == 3 ? 2 : 1); ++rep) { __syncthreads(); sb_phase(lds, P0, P1, P2, P3, P4, args.in[15], args.in[16], G, blk); }
    }
    SEAM(11);
    if (IN(12)) GEMM_PHASE(EpiResid, P4, WA_out, 2048, 2048, H, nullptr, H, PS);
    SEAM(12);
    if (IN(13)) rs_phase(PS, RS, G, blk);
    SEAM(13);
    if (IN(14)) GEMM_PHASE_P(EpiConvFused, H, WB_in, 8192, 2048, P2, VBH, BGH, RS, args.in[3] + 3 * 2048, args.in[4] + 2048);
    SEAM(14);
    if (IN(15)) conv_fix_phase(VBH, BGH, P2, args.in[3] + 3 * 2048, args.in[4] + 2048, G, blk);
    SEAM(15);
    if (IN(16)) GEMM_PHASE(EpiResid, P2, WB_out_conv, 2048, 2048, H, xo, nullptr, nullptr);
#undef IN
#undef SEAM
#undef GEMM_PHASE
}

extern "C" void kernel_launch(void* const* d_in, const int* in_sizes, int n_in, void* d_out, int out_size, void* d_ws, size_t ws_size, hipStream_t stream) {
    static int ready = 0;
    if (ready == 0) {
        if (n_in != 18 || in_sizes[0] != M * DM || out_size != M * DM || ws_size < WS_END) {
            fprintf(stderr, "kernel_launch: unexpected problem shape / workspace (n_in %d, in0 %d, out %d, ws %zu); nothing launched\n", n_in, n_in > 0 ? in_sizes[0] : -1, out_size, ws_size);
            ready = -1; return;
        }
        if (hipFuncSetAttribute((const void*)hybrid_fwd, hipFuncAttributeMaxDynamicSharedMemorySize, LDS_BYTES) != hipSuccess) { fprintf(stderr, "kernel_launch: hipFuncSetAttribute failed\n"); ready = -1; return; }
        int per_cu = 0;
        if (hipOccupancyMaxActiveBlocksPerMultiprocessor(&per_cu, (const void*)hybrid_fwd, NTHREADS, LDS_BYTES) != hipSuccess || per_cu < 1) fprintf(stderr, "kernel_launch: occupancy query says %d blocks/CU\n", per_cu);
        (void)hipGetLastError();
        ready = 1;
    }
    if (ready < 0) return;
    if (hipMemsetAsync(d_ws, 0, 65536, stream) != hipSuccess) { fprintf(stderr, "kernel_launch: hipMemsetAsync of the barrier words failed\n"); return; }
    Args a{};
    for (int i = 0; i < 18; ++i) a.in[i] = (const float*)d_in[i];
    a.out = (float*)d_out; a.ws = (unsigned char*)d_ws;
    const int grid = 256;
#if MK_PER_PHASE
    for (int p = 0; p < NPHASE; ++p) { a.ph_lo = p; a.ph_hi = p + 1; hipLaunchKernelGGL(hybrid_fwd, dim3(grid), dim3(NTHREADS), LDS_BYTES, stream, a); }
#else
    a.ph_lo = 0; a.ph_hi = NPHASE;
    void* kargs[] = {&a};
    hipError_t e = hipLaunchCooperativeKernel((const void*)hybrid_fwd, dim3(grid), dim3(NTHREADS), kargs, LDS_BYTES, stream);
    if (e != hipSuccess) fprintf(stderr, "kernel_launch: cooperative launch failed: %s\n", hipGetErrorString(e));
#endif
}
```

```cpp
#include <hip/hip_runtime.h>
#include <hip/hip_cooperative_groups.h>
#include <hip/amd_detail/amd_hip_unsafe_atomics.h>
#include <cstdio>
#include <cstdint>
namespace cg = cooperative_groups;
namespace pg8 {
#define PG8_LAS __attribute__((address_space(3)))
typedef unsigned short bf16_t;
typedef short bf16x8 __attribute__((ext_vector_type(8)));
typedef float f32x4 __attribute__((ext_vector_type(4)));
typedef unsigned u32x4 __attribute__((ext_vector_type(4)));
constexpr int BM = 256, BK = 64, HALF = 128, HTB = HALF * BK * 2  , STAGE_BYTES = 8 * HTB, NXCD = 8, WGM = 8;

__host__ __device__ __forceinline__ int lds_byte(int r, int c) { const int st = (r >> 4) * 2 + (c >> 5), rr = r & 15, cc = c & 31, ob = rr * 64 + cc * 2; return st * 1024 + (ob ^ (((ob >> 9) & 1) << 5)); }
__host__ __device__ __forceinline__ void stage_rc(int b, int& R, int& C) { const int st = b / 1024, sb = b % 1024, swz = sb ^ (((sb >> 9) & 1) << 5); R = (st >> 1) * 16 + swz / 64; C = (st & 1) * 32 + (swz % 64) / 2; }
__host__ __device__ __forceinline__ int perm32(int rho) { const int n = rho >> 4, i = rho & 15; return 8 * (i >> 2) + 4 * n + (i & 3); }

struct Unit { int pm, pn; };
struct Gemm { const bf16_t* A; const bf16_t* Bt; int M, N, K; };

struct StaticOrder {
    int nM, nN, nwg, G, c;
    __host__ __device__ void init(int M, int N, int G_, int c_) { nM = M / BM; nN = N / BM; nwg = nM * nN; G = G_; c = c_; }
    __host__ __device__ bool next(int i, Unit& u) const {
        const long L = (long)i * G + c; if (L >= nwg) return false;
        int wgid = (int)L; { const int q = nwg / NXCD, r = nwg % NXCD, xcd = wgid % NXCD, off = wgid / NXCD; wgid = (xcd < r ? xcd * (q + 1) : r * (q + 1) + (xcd - r) * q) + off; }
        const int nig = WGM * nN, gid = wgid / nig, fm = gid * WGM, gsz = (nM - fm) < WGM ? (nM - fm) : WGM;
        u.pm = fm + ((wgid % nig) % gsz); u.pn = (wgid % nig) / gsz; return true;
    }
    __device__ __forceinline__ void a_ready(const Unit&) const {}
    __device__ __forceinline__ void done(const Unit&) const {}
};

typedef __bf16 bf2_t __attribute__((ext_vector_type(2)));
typedef float f32x2 __attribute__((ext_vector_type(2)));
__device__ __forceinline__ unsigned cvt_pk_bf16(float lo, float hi) { f32x2 v = {lo, hi}; return __builtin_bit_cast(unsigned, __builtin_convertvector(v, bf2_t)); }
template <class Epi, class Sched, bool ALIGN_EPI = false, bool SP2 = false>
__device__ __forceinline__ void gemm_phase(PG8_LAS unsigned char* lds, const Gemm g, const Sched& S, const Epi& E) {
    const int tid = threadIdx.x, wid = __builtin_amdgcn_readfirstlane(tid >> 6), lane = tid & 63, wr = wid >> 2, wc = wid & 3, fr = lane & 15, fq = lane >> 4;
    const int K = g.K, nt = K / BK;
    unsigned voffA[2], voffB[2];
#pragma unroll
    for (int i = 0; i < 2; ++i) { int R, C; stage_rc(tid * 16 + i * 8192, R, C); const int Rb = Epi::PERM ? ((R & ~31) + perm32(R & 31)) : R;
        voffA[i] = (unsigned)(R * K + C) * 2u; voffB[i] = (unsigned)(Rb * K + C) * 2u; }
    const size_t kstep = (size_t)(BK * 2);
    const size_t hstep = (size_t)HALF * K * 2;
    const size_t tstep = 2 * hstep;
    const unsigned ldsw = (unsigned)wid * 1024u;
    const int aoff = lds_byte(wr * 64 + fr, fq * 8), boff = lds_byte(wc * 32 + fr, fq * 8);
#define PG8_SA(b, h) (((b) * 2 + (h)) * HTB)
#define PG8_SB(b, h) ((4 + (b) * 2 + (h)) * HTB)
#define PG8_STAGE(bufoff, gbase, voff) do { _Pragma("unroll") for (int _i = 0; _i < 2; ++_i) \
        __builtin_amdgcn_global_load_lds((const unsigned*)((const char*)(gbase) + (voff)[_i]), (PG8_LAS unsigned*)(lds + (bufoff) + ldsw + _i * 8192), 16, 0, 0); } while (0)
#define PG8_LDA(dst, b, h) do { _Pragma("unroll") for (int m = 0; m < 4; ++m) _Pragma("unroll") for (int k = 0; k < 2; ++k) dst[m][k] = *(const PG8_LAS bf16x8*)(lds + PG8_SA(b, h) + aoff + m * 2048 + k * 1024); } while (0)
#define PG8_LDB(dst, b, h) do { _Pragma("unroll") for (int n = 0; n < 2; ++n) _Pragma("unroll") for (int k = 0; k < 2; ++k) dst[n][k] = *(const PG8_LAS bf16x8*)(lds + PG8_SB(b, h) + boff + n * 2048 + k * 1024); } while (0)
#define PG8_MMA(ai, bj, At, Bt) do { __builtin_amdgcn_s_setprio(1); _Pragma("unroll") for (int m = 0; m < 4; ++m) _Pragma("unroll") for (int n = 0; n < 2; ++n) _Pragma("unroll") for (int k = 0; k < 2; ++k) \
        acc[ai][bj][m][n] = __builtin_amdgcn_mfma_f32_16x16x32_bf16(Bt[n][k], At[m][k], acc[ai][bj][m][n], 0, 0, 0); __builtin_amdgcn_s_setprio(0); } while (0)
#define PG8_WAIT_V(n) asm volatile("s_waitcnt vmcnt(" #n ")" ::: "memory")
#define PG8_WAIT_L(n) asm volatile("s_waitcnt lgkmcnt(" #n ")" ::: "memory")
#define PG8_BAR __builtin_amdgcn_s_barrier()
#define PG8_SCHED __builtin_amdgcn_sched_barrier(0)
    Unit cur, nxt; int ui = 0;
    if (!S.next(0, cur)) return;
    f32x4 acc[2][2][4][2];
#pragma unroll
    for (int a = 0; a < 2; ++a)
#pragma unroll
        for (int b = 0; b < 2; ++b)
#pragma unroll
            for (int m = 0; m < 4; ++m)
#pragma unroll
                for (int n = 0; n < 2; ++n) acc[a][b][m][n] = (f32x4){0.f, 0.f, 0.f, 0.f};
    bf16x8 At[4][2], B0[2][2], B1[2][2];
    const char* cA = (const char*)g.A + (size_t)cur.pm * tstep; const char* cB = (const char*)g.Bt + (size_t)cur.pn * tstep;
    S.a_ready(cur);
    if constexpr (SP2) {
        PG8_STAGE(PG8_SB(0, 0), cB, voffB); PG8_STAGE(PG8_SB(0, 1), cB + hstep, voffB); PG8_STAGE(PG8_SA(0, 0), cA, voffA); PG8_STAGE(PG8_SA(0, 1), cA + hstep, voffA);
        if (wr == 1) PG8_BAR;
        PG8_WAIT_V(2); PG8_BAR;
        PG8_STAGE(PG8_SB(1, 0), cB + kstep, voffB); PG8_STAGE(PG8_SA(1, 0), cA + kstep, voffA); PG8_STAGE(PG8_SB(1, 1), cB + hstep + kstep, voffB);
        PG8_WAIT_V(6); PG8_BAR;
    } else {
        PG8_STAGE(PG8_SB(0, 0), cB, voffB); PG8_STAGE(PG8_SA(0, 0), cA, voffA); PG8_STAGE(PG8_SB(0, 1), cB + hstep, voffB); PG8_STAGE(PG8_SA(0, 1), cA + hstep, voffA);
        if (wr == 1) PG8_BAR;
        PG8_WAIT_V(4); PG8_BAR;
        PG8_STAGE(PG8_SB(1, 0), cB + kstep, voffB); PG8_STAGE(PG8_SA(1, 0), cA + kstep, voffA); PG8_STAGE(PG8_SB(1, 1), cB + hstep + kstep, voffB);
        PG8_WAIT_V(6); PG8_BAR;
    }
    for (;;) {
        const bool has_next = S.next(ui + 1, nxt);
        const char* nA = has_next ? (const char*)g.A + (size_t)nxt.pm * tstep : cA; const char* nB = has_next ? (const char*)g.Bt + (size_t)nxt.pn * tstep : cB;
        for (int t = 0; t < nt; t += 2) {
            const bool last = (t == nt - 2);
            const char* a1 = cA + (size_t)(t + 1) * kstep;
            const char* a2 = last ? nA : cA + (size_t)(t + 2) * kstep; const char* b2 = last ? nB : cB + (size_t)(t + 2) * kstep;
            const char* a3 = a2 + kstep; const char* b3 = b2 + kstep;
            if (last && has_next) S.a_ready(nxt);
            if constexpr (SP2) {
            PG8_LDB(B0, 0, 0); PG8_LDB(B1, 0, 1); PG8_SCHED; PG8_LDA(At, 0, 0); PG8_STAGE(PG8_SA(1, 1), a1 + hstep, voffA);
            PG8_WAIT_V(8); PG8_WAIT_L(0); PG8_BAR; PG8_MMA(0, 0, At, B0); PG8_MMA(0, 1, At, B1); PG8_BAR; PG8_SCHED;
            PG8_LDA(At, 0, 1); PG8_STAGE(PG8_SB(0, 0), b2, voffB); PG8_STAGE(PG8_SB(0, 1), b2 + hstep, voffB); PG8_STAGE(PG8_SA(0, 0), a2, voffA);
            PG8_WAIT_V(8); PG8_WAIT_L(0); PG8_BAR; PG8_MMA(1, 0, At, B0); PG8_MMA(1, 1, At, B1); PG8_BAR; PG8_SCHED;
            PG8_LDB(B0, 1, 0); PG8_LDB(B1, 1, 1); PG8_SCHED; PG8_LDA(At, 1, 0); PG8_STAGE(PG8_SA(0, 1), a2 + hstep, voffA);
            PG8_WAIT_V(8); PG8_WAIT_L(0); PG8_BAR; PG8_MMA(0, 0, At, B0); PG8_MMA(0, 1, At, B1); PG8_BAR; PG8_SCHED;
            PG8_LDA(At, 1, 1); PG8_STAGE(PG8_SB(1, 0), b3, voffB); PG8_STAGE(PG8_SB(1, 1), b3 + hstep, voffB); PG8_STAGE(PG8_SA(1, 0), a3, voffA);
            PG8_WAIT_V(8); PG8_WAIT_L(0); PG8_BAR; PG8_MMA(1, 0, At, B0); PG8_MMA(1, 1, At, B1); PG8_BAR; PG8_SCHED;
            } else {
            PG8_LDB(B0, 0, 0); PG8_SCHED; PG8_LDA(At, 0, 0); PG8_STAGE(PG8_SA(1, 1), a1 + hstep, voffA);
            PG8_WAIT_L(8); PG8_BAR; PG8_WAIT_L(0); PG8_MMA(0, 0, At, B0); PG8_BAR; PG8_SCHED;
            PG8_LDB(B1, 0, 1); PG8_STAGE(PG8_SB(0, 0), b2, voffB);
            PG8_BAR; PG8_WAIT_L(0); PG8_MMA(0, 1, At, B1); PG8_BAR;
            PG8_LDA(At, 0, 1); PG8_STAGE(PG8_SA(0, 0), a2, voffA);
            PG8_BAR; PG8_WAIT_L(0); PG8_MMA(1, 0, At, B0); PG8_BAR; PG8_SCHED;
            PG8_STAGE(PG8_SB(0, 1), b2 + hstep, voffB);
            PG8_WAIT_V(6); PG8_BAR; PG8_MMA(1, 1, At, B1); PG8_BAR;
            PG8_LDB(B0, 1, 0); PG8_SCHED; PG8_LDA(At, 1, 0); PG8_STAGE(PG8_SA(0, 1), a2 + hstep, voffA);
            PG8_WAIT_L(8); PG8_BAR; PG8_WAIT_L(0); PG8_MMA(0, 0, At, B0); PG8_BAR; PG8_SCHED;
            PG8_LDB(B1, 1, 1); PG8_STAGE(PG8_SB(1, 0), b3, voffB);
            PG8_BAR; PG8_WAIT_L(0); PG8_MMA(0, 1, At, B1); PG8_BAR;
            PG8_LDA(At, 1, 1); PG8_STAGE(PG8_SA(1, 0), a3, voffA);
            PG8_BAR; PG8_WAIT_L(0); PG8_MMA(1, 0, At, B0); PG8_BAR; PG8_SCHED;
            PG8_STAGE(PG8_SB(1, 1), b3 + hstep, voffB);
            PG8_WAIT_V(6); PG8_BAR; PG8_MMA(1, 1, At, B1); PG8_BAR;
            }
        }
        if constexpr (ALIGN_EPI) { if (wr == 0) PG8_BAR; }
        if constexpr (!Epi::AFTER_DRAIN) { E(acc, cur, wr, wc, fr, fq); S.done(cur); }
        if (!has_next) break;
#pragma unroll
        for (int a = 0; a < 2; ++a)
#pragma unroll
            for (int b = 0; b < 2; ++b)
#pragma unroll
                for (int m = 0; m < 4; ++m)
#pragma unroll
                    for (int n = 0; n < 2; ++n) acc[a][b][m][n] = (f32x4){0.f, 0.f, 0.f, 0.f};
        cur = nxt; cA = nA; cB = nB; ++ui;
        if constexpr (ALIGN_EPI) { if (wr == 1) PG8_BAR; }
    }
    PG8_WAIT_V(0);
    if constexpr (!ALIGN_EPI) { if (wr == 0) PG8_BAR; }
    PG8_BAR;
    if constexpr (Epi::AFTER_DRAIN) { E.fused(acc, cur, wr, wc, fr, fq, lds, wid, lane); S.done(cur); }
#undef PG8_SA
#undef PG8_SB
#undef PG8_STAGE
#undef PG8_LDA
#undef PG8_LDB
#undef PG8_MMA
#undef PG8_WAIT_V
#undef PG8_WAIT_L
#undef PG8_BAR
#undef PG8_SCHED
}
}

#define DI __device__ __forceinline__
#define LAS __attribute__((address_space(3)))
#define GAS __attribute__((address_space(1)))
typedef unsigned short bf16;
typedef float f32x4 __attribute__((ext_vector_type(4)));
typedef float f32x16 __attribute__((ext_vector_type(16)));
typedef short bf16x8 __attribute__((ext_vector_type(8)));
typedef short s16x4 __attribute__((ext_vector_type(4)));
typedef unsigned u32x4 __attribute__((ext_vector_type(4)));
typedef unsigned u32x2 __attribute__((ext_vector_type(2)));

#ifndef PROBE
#define PROBE 0
#endif
#ifndef GEMM_ALIGN
#define GEMM_ALIGN true
#endif
#ifndef GEMM_SP2
#define GEMM_SP2 true
#endif
#ifndef MK_PER_PHASE
#define MK_PER_PHASE 0
#endif

constexpr int NWAVES = 8, NTHREADS = 512;
constexpr int BATCH = 16, SEQ = 2048, DM = 2048, M = BATCH * SEQ;
constexpr int NPHASE = 17;
constexpr size_t MiB = 1u << 20;
constexpr size_t WS_WA = 1 * MiB, WS_WB = 41 * MiB, WS_H = 105 * MiB, WS_P = 233 * MiB, WS_PS = 1001 * MiB, WS_END = 1017 * MiB;
constexpr int LDS_BYTES = 147456;

DI unsigned pk2(float lo, float hi) { return pg8::cvt_pk_bf16(lo, hi); }
DI float bflo(unsigned u) { return __uint_as_float(u << 16); }
DI float bfhi(unsigned u) { return __uint_as_float(u & 0xffff0000u); }
DI float bf2f(bf16 v) { return __uint_as_float(((unsigned)v) << 16); }
DI bf16 f2bf(float f) { return (bf16)(pk2(f, 0.f) & 0xffffu); }
DI float silu_f(float g) { return g * __builtin_amdgcn_rcpf(1.f + __expf(-g)); }
DI float wave_sum(float v) {
#pragma unroll
    for (int o = 1; o < 64; o <<= 1) v += __shfl_xor(v, o);
    return v;
}
DI int launder(int x) { asm volatile("" : "+v"(x)); return x; }
DI int crow(int i, int hh) { return (i & 3) + 8 * (i >> 2) + 4 * hh; }
#define LDS_WAIT() asm volatile("s_waitcnt lgkmcnt(0)" ::: "memory")
#define MFMA32(a, b, c) __builtin_amdgcn_mfma_f32_32x32x16_bf16((a), (b), (c), 0, 0, 0)

template <int S> DI bf16x8 pack_step(const f32x16& x) {
    u32x4 p;
    p.x = pk2(x[8 * S + 0], x[8 * S + 1]); p.y = pk2(x[8 * S + 2], x[8 * S + 3]);
    p.z = pk2(x[8 * S + 4], x[8 * S + 5]); p.w = pk2(x[8 * S + 6], x[8 * S + 7]);
    return __builtin_bit_cast(bf16x8, p);
}
DI bf16x8 tr_frag(const LAS unsigned char* img, int pitch, int row0, int row1, int colbyte, int q4) {
    const s16x4 lo = __builtin_amdgcn_ds_read_tr16_b64_v4i16((LAS s16x4*)(img + (row0 + q4) * pitch + colbyte));
    const s16x4 hi = __builtin_amdgcn_ds_read_tr16_b64_v4i16((LAS s16x4*)(img + (row1 + q4) * pitch + colbyte));
    return __builtin_shufflevector(lo, hi, 0, 1, 2, 3, 4, 5, 6, 7);
}

namespace pg8 {
struct EpiConvFused {
    static constexpr bool PERM = false, AFTER_DRAIN = false;
    bf16_t* Y; bf16_t* VB; bf16_t* BGB; const float* SS; const float* cw; const float* cb;
    template <int CTRL> static __device__ __forceinline__ float dppf(float f) { const int x = __builtin_bit_cast(int, f); return __builtin_bit_cast(float, __builtin_amdgcn_update_dpp(x, x, CTRL, 0xf, 0xf, false)); }
    template <int CTRL> static __device__ __forceinline__ f32x4 rorv(const f32x4 v) { f32x4 o; o.x = dppf<CTRL>(v.x); o.y = dppf<CTRL>(v.y); o.z = dppf<CTRL>(v.z); o.w = dppf<CTRL>(v.w); return o; }
    __device__ __forceinline__ void operator()(const f32x4 (&acc)[2][2][4][2], const Unit& u, int wr, int wc, int fr, int fq) const {
        typedef unsigned u2 __attribute__((ext_vector_type(2)));
        const int row0 = u.pm * BM + wr * 64 + fr, ch = u.pn * 64 + wc * 16 + fq * 4;
        float rsv[2][4];
#pragma unroll
        for (int ai = 0; ai < 2; ++ai)
#pragma unroll
            for (int m = 0; m < 4; ++m) rsv[ai][m] = SS ? SS[row0 + ai * HALF + m * 16] : 1.f;
        const f32x4 w0 = *(const f32x4*)(cw + ch), w1 = *(const f32x4*)(cw + 2048 + ch), w2 = *(const f32x4*)(cw + 4096 + ch), bb = *(const f32x4*)(cb + ch);
#pragma unroll
        for (int ai = 0; ai < 2; ++ai) {
            const int slab = u.pm * 4 + ai * 2 + wr;
            f32x4 vprev = {0.f, 0.f, 0.f, 0.f};
#pragma unroll
            for (int m = 0; m < 4; ++m) {
                const int row = row0 + ai * HALF + m * 16;
                const float rs = rsv[ai][m];
                const f32x4 b = acc[ai][0][m][0] * rs, c = acc[ai][0][m][1] * rs, uu = acc[ai][1][m][0] * rs, g = acc[ai][1][m][1] * rs;
                const f32x4 v = c * uu;
                f32x4 sg;
#pragma unroll
                for (int e = 0; e < 4; ++e) sg[e] = b[e] * g[e] * __builtin_amdgcn_rcpf(1.f + __expf(-g[e]));
                const f32x4 a1 = rorv<0x121>(v), a2 = rorv<0x122>(v), q1 = rorv<0x121>(vprev), q2 = rorv<0x122>(vprev);
                const f32x4 p1 = (fr == 0) ? q1 : a1, p2 = (fr < 2) ? q2 : a2;
                const f32x4 y = sg * (bb + w0 * p2 + w1 * p1 + w2 * v);
                u2 wy; wy.x = cvt_pk_bf16(y[0], y[1]); wy.y = cvt_pk_bf16(y[2], y[3]);
                u2 wv; wv.x = cvt_pk_bf16(v[0], v[1]); wv.y = cvt_pk_bf16(v[2], v[3]);
                if (m == 0) {
                    if (fr >= 2) *(u2*)(Y + (size_t)row * 2048 + ch) = wy;
                    else { u2 ws; ws.x = cvt_pk_bf16(sg[0], sg[1]); ws.y = cvt_pk_bf16(sg[2], sg[3]);
                           *(u2*)(VB + ((size_t)slab * 4 + 2 + fr) * 2048 + ch) = wv; *(u2*)(BGB + ((size_t)slab * 2 + fr) * 2048 + ch) = ws; }
                } else {
                    *(u2*)(Y + (size_t)row * 2048 + ch) = wy;
                    if (m == 3 && fr >= 14) *(u2*)(VB + ((size_t)slab * 4 + (fr - 14)) * 2048 + ch) = wv;
                }
                vprev = v;
            }
        }
    }
};
struct EpiResid {
    static constexpr bool PERM = true, AFTER_DRAIN = false;
    const bf16_t* base16; float* out32; bf16_t* XB; float* SS;
    __device__ __forceinline__ void operator()(const f32x4 (&acc)[2][2][4][2], const Unit& u, int wr, int wc, int fr, int fq) const {
        const int row0 = u.pm * BM + wr * 64 + fr, col0 = u.pn * BM + wc * 32 + 8 * fq;
#pragma unroll
        for (int ai = 0; ai < 2; ++ai) {
            u32x4 raw[4][2];
#pragma unroll
            for (int m = 0; m < 4; ++m)
#pragma unroll
                for (int bj = 0; bj < 2; ++bj) raw[m][bj] = *(const u32x4*)(base16 + (size_t)(row0 + ai * HALF + m * 16) * 2048 + col0 + bj * HALF);
#pragma unroll
            for (int m = 0; m < 4; ++m) {
                const int row = row0 + ai * HALF + m * 16;
                const size_t off = (size_t)row * 2048 + col0;
                float sq = 0.f;
#pragma unroll
                for (int bj = 0; bj < 2; ++bj) {
                    const u32x4 w = raw[m][bj];
                    const f32x4 r0 = {__uint_as_float(w.x << 16), __uint_as_float(w.x & 0xffff0000u), __uint_as_float(w.y << 16), __uint_as_float(w.y & 0xffff0000u)};
                    const f32x4 r1 = {__uint_as_float(w.z << 16), __uint_as_float(w.z & 0xffff0000u), __uint_as_float(w.w << 16), __uint_as_float(w.w & 0xffff0000u)};
                    const f32x4 v0 = r0 + acc[ai][bj][m][0], v1 = r1 + acc[ai][bj][m][1];
                    if (out32) { *(f32x4*)(out32 + off + bj * HALF) = v0; *(f32x4*)(out32 + off + bj * HALF + 4) = v1; }
                    if (XB) { u32x4 o; o.x = cvt_pk_bf16(v0[0], v0[1]); o.y = cvt_pk_bf16(v0[2], v0[3]); o.z = cvt_pk_bf16(v1[0], v1[1]); o.w = cvt_pk_bf16(v1[2], v1[3]);
                              *(u32x4*)(XB + off + bj * HALF) = o;
                              sq += ((v0[0] * v0[0] + v0[1] * v0[1]) + (v0[2] * v0[2] + v0[3] * v0[3])) + ((v1[0] * v1[0] + v1[1] * v1[1]) + (v1[2] * v1[2] + v1[3] * v1[3])); }
                }
                if (XB) { sq += __shfl_xor(sq, 16); sq += __shfl_xor(sq, 32); if (fq == 0) SS[(size_t)row * 32 + u.pn * 4 + wc] = sq; }
            }
        }
    }
};
struct EpiSplitRet {
    static constexpr bool PERM = true, AFTER_DRAIN = false;
    bf16_t *Oq, *Ok, *Ov, *Og; const float* SS; const float* qg; const float* kg; __attribute__((address_space(3))) float* xl;
    __device__ __forceinline__ void operator()(const f32x4 (&acc)[2][2][4][2], const Unit& u, int wr, int wc, int fr, int fq) const {
        const int row0 = u.pm * BM + wr * 64 + fr;
        float rsv[2][4];
#pragma unroll
        for (int ai = 0; ai < 2; ++ai)
#pragma unroll
            for (int m = 0; m < 4; ++m) rsv[ai][m] = SS[row0 + ai * HALF + m * 16];
        if (u.pn >= 16) {
            bf16_t* base = (u.pn >= 32) ? Og : Ov; const int ct = (u.pn >= 32) ? u.pn - 32 : u.pn - 16;
            const int col0 = ct * BM + wc * 32 + 8 * fq;
#pragma unroll
            for (int ai = 0; ai < 2; ++ai)
#pragma unroll
                for (int m = 0; m < 4; ++m) {
                    bf16_t* rowp = base + (size_t)(row0 + ai * HALF + m * 16) * 4096 + col0; const float rs = rsv[ai][m];
#pragma unroll
                    for (int bj = 0; bj < 2; ++bj) {
                        const f32x4 v0 = acc[ai][bj][m][0] * rs, v1 = acc[ai][bj][m][1] * rs;
                        u32x4 w; w.x = cvt_pk_bf16(v0[0], v0[1]); w.y = cvt_pk_bf16(v0[2], v0[3]); w.z = cvt_pk_bf16(v1[0], v1[1]); w.w = cvt_pk_bf16(v1[2], v1[3]);
                        *(u32x4*)(rowp + bj * HALF) = w;
                    }
                }
            return;
        }
        const bool isK = u.pn >= 8; const int h = u.pn & 7;
        bf16_t* base = isK ? Ok : Oq; const float* gn = isK ? kg : qg;
        const int d0 = wc * 32 + 8 * fq;
#pragma unroll
        for (int ai = 0; ai < 2; ++ai)
#pragma unroll
            for (int m = 0; m < 4; ++m) {
                float sq = 0.f;
#pragma unroll
                for (int bj = 0; bj < 2; ++bj)
#pragma unroll
                    for (int n = 0; n < 2; ++n) { const f32x4 v = acc[ai][bj][m][n]; sq += (v[0] * v[0] + v[1] * v[1]) + (v[2] * v[2] + v[3] * v[3]); }
                sq += __shfl_xor(sq, 16); sq += __shfl_xor(sq, 32);
                if (fq == 0) xl[(ai * HALF + wr * 64 + m * 16 + fr) * 4 + wc] = sq * rsv[ai][m] * rsv[ai][m];
            }
        asm volatile("s_waitcnt lgkmcnt(0)" ::: "memory"); __builtin_amdgcn_s_barrier(); asm volatile("" ::: "memory");
        const float l2g = log2f(1.f - exp2f(-5.f - (float)h));
        float invf[8], g1[8], g2[8];
#pragma unroll
        for (int j = 0; j < 8; ++j) { invf[j] = exp2f(-(float)(d0 + j) * (13.287712379549449f / 128.f)); g1[j] = gn[d0 + j]; g2[j] = gn[128 + d0 + j]; }
#pragma unroll
        for (int ai = 0; ai < 2; ++ai)
#pragma unroll
            for (int m = 0; m < 4; ++m) {
                const int rl = ai * HALF + wr * 64 + m * 16 + fr, row = u.pm * BM + rl, t = row & 2047;
                const f32x4 pp = *(const __attribute__((address_space(3))) f32x4*)(xl + rl * 4);
                const float ss = (pp[0] + pp[1]) + (pp[2] + pp[3]);
                const float dq = exp2f((float)((t & 63) + 1) * l2g);
                const float scl = rsqrtf(ss * (1.f / 256.f) + 1e-6f) * rsv[ai][m] * (isK ? 0.0625f / dq : dq);
                const float pos = (float)t;
                f32x4 o1[2], o2[2];
#pragma unroll
                for (int n = 0; n < 2; ++n)
#pragma unroll
                    for (int e = 0; e < 4; ++e) {
                        const int j = 4 * n + e;
                        float rev = (pos * invf[j]) * 0.15915494309189535f; rev = __builtin_amdgcn_fractf(rev);
                        const float sn = __builtin_amdgcn_sinf(rev), cs = __builtin_amdgcn_cosf(rev);
                        const float x1 = acc[ai][0][m][n][e] * g1[j], x2 = acc[ai][1][m][n][e] * g2[j];
                        o1[n][e] = (x1 * cs - x2 * sn) * scl; o2[n][e] = (x2 * cs + x1 * sn) * scl;
                    }
                bf16_t* rowp = base + (size_t)row * 2048 + h * 256 + d0;
                u32x4 w;
                w.x = cvt_pk_bf16(o1[0][0], o1[0][1]); w.y = cvt_pk_bf16(o1[0][2], o1[0][3]); w.z = cvt_pk_bf16(o1[1][0], o1[1][1]); w.w = cvt_pk_bf16(o1[1][2], o1[1][3]);
                *(u32x4*)(rowp) = w;
                w.x = cvt_pk_bf16(o2[0][0], o2[0][1]); w.y = cvt_pk_bf16(o2[0][2], o2[0][3]); w.z = cvt_pk_bf16(o2[1][0], o2[1][1]); w.w = cvt_pk_bf16(o2[1][2], o2[1][3]);
                *(u32x4*)(rowp + HALF) = w;
            }
        asm volatile("s_waitcnt lgkmcnt(0)" ::: "memory"); __builtin_amdgcn_s_barrier(); asm volatile("" ::: "memory");
    }
};
struct EpiSplitSb {
    static constexpr bool PERM = true, AFTER_DRAIN = false;
    bf16_t *Oq, *Ok, *Ov, *Og; const float* SS; const float* qg; const float* kg; __attribute__((address_space(3))) float* xl;
    __device__ __forceinline__ void operator()(const f32x4 (&acc)[2][2][4][2], const Unit& u, int wr, int wc, int fr, int fq) const {
        const int row0 = u.pm * BM + wr * 64 + fr;
        float rsv[2][4];
#pragma unroll
        for (int ai = 0; ai < 2; ++ai)
#pragma unroll
            for (int m = 0; m < 4; ++m) rsv[ai][m] = SS[row0 + ai * HALF + m * 16];
        const int sec = u.pn >> 3, ct = u.pn & 7;
        bf16_t* base = sec == 0 ? Oq : (sec == 1 ? Ok : (sec == 2 ? Ov : Og));
        const int col0 = ct * BM + wc * 32 + 8 * fq;
        if (sec >= 2) {
#pragma unroll
            for (int ai = 0; ai < 2; ++ai)
#pragma unroll
                for (int m = 0; m < 4; ++m) {
                    bf16_t* rowp = base + (size_t)(row0 + ai * HALF + m * 16) * 2048 + col0; const float rs = rsv[ai][m];
#pragma unroll
                    for (int bj = 0; bj < 2; ++bj) {
                        const f32x4 v0 = acc[ai][bj][m][0] * rs, v1 = acc[ai][bj][m][1] * rs;
                        u32x4 w; w.x = cvt_pk_bf16(v0[0], v0[1]); w.y = cvt_pk_bf16(v0[2], v0[3]); w.z = cvt_pk_bf16(v1[0], v1[1]); w.w = cvt_pk_bf16(v1[2], v1[3]);
                        *(u32x4*)(rowp + bj * HALF) = w;
                    }
                }
            return;
        }
        const float* gn = sec ? kg : qg; const float post = sec ? 1.f : 0.12751743f;
#pragma unroll
        for (int ai = 0; ai < 2; ++ai)
#pragma unroll
            for (int m = 0; m < 4; ++m)
#pragma unroll
                for (int bj = 0; bj < 2; ++bj) {
                    const f32x4 a = acc[ai][bj][m][0], b = acc[ai][bj][m][1];
                    float sq = ((a[0] * a[0] + a[1] * a[1]) + (a[2] * a[2] + a[3] * a[3])) + ((b[0] * b[0] + b[1] * b[1]) + (b[2] * b[2] + b[3] * b[3]));
                    sq += __shfl_xor(sq, 16); sq += __shfl_xor(sq, 32);
                    if (fq == 0) xl[((ai * HALF + wr * 64 + m * 16 + fr) * 2 + bj) * 4 + wc] = sq;
                }
        asm volatile("s_waitcnt lgkmcnt(0)" ::: "memory"); __builtin_amdgcn_s_barrier(); asm volatile("" ::: "memory");
        const f32x4 ga = *(const f32x4*)(gn + wc * 32 + 8 * fq), gb = *(const f32x4*)(gn + wc * 32 + 8 * fq + 4);
#pragma unroll
        for (int ai = 0; ai < 2; ++ai)
#pragma unroll
            for (int m = 0; m < 4; ++m) {
                const int rl = ai * HALF + wr * 64 + m * 16 + fr; const float rs = rsv[ai][m];
                bf16_t* rowp = base + (size_t)(u.pm * BM + rl) * 2048 + col0;
#pragma unroll
                for (int bj = 0; bj < 2; ++bj) {
                    const f32x4 pp = *(const __attribute__((address_space(3))) f32x4*)(xl + (rl * 2 + bj) * 4);
                    const float ss = ((pp[0] + pp[1]) + (pp[2] + pp[3])) * rs * rs;
                    const float scl = rsqrtf(ss * (1.f / 128.f) + 1e-6f) * rs * post;
                    const f32x4 v0 = acc[ai][bj][m][0] * ga * scl, v1 = acc[ai][bj][m][1] * gb * scl;
                    u32x4 w; w.x = cvt_pk_bf16(v0[0], v0[1]); w.y = cvt_pk_bf16(v0[2], v0[3]); w.z = cvt_pk_bf16(v1[0], v1[1]); w.w = cvt_pk_bf16(v1[2], v1[3]);
                    *(u32x4*)(rowp + bj * HALF) = w;
                }
            }
        asm volatile("s_waitcnt lgkmcnt(0)" ::: "memory"); __builtin_amdgcn_s_barrier(); asm volatile("" ::: "memory");
    }
};
}

DI int conv_perm(int s) {
    const int sec = s >> 11, ch = s & 2047;
    return 256 * (ch >> 6) + 128 * (sec >> 1) + 32 * ((ch >> 4) & 3) + 16 * (sec & 1) + 4 * ((ch >> 2) & 3) + (ch & 3);
}
template <bool CONVPERM>
DI void transpose_item(const float* W, const float* gain, int K, int N, bf16* WT, LAS float* scr, int item, int lane) {
    const int nblk = N / 32, kb = item / nblk, nb = item % nblk, k0 = 64 * kb, n0 = 32 * nb;
    float tv[32];
#pragma unroll
    for (int i = 0; i < 32; ++i) { const int kk = 2 * i + (lane >> 5); tv[i] = W[(size_t)(k0 + kk) * N + n0 + (lane & 31)]; }
#pragma unroll
    for (int i = 0; i < 32; ++i) { const int kk = 2 * i + (lane >> 5); scr[kk * 33 + (lane & 31)] = tv[i] * (gain ? gain[k0 + kk] : 1.f); }
    LDS_WAIT(); asm volatile("" ::: "memory");
    const int c = lane & 7;
#pragma unroll
    for (int j = 0; j < 4; ++j) {
        const int n = (lane >> 3) + 8 * j; const LAS float* s = scr + (8 * c) * 33 + n;
        u32x4 o; o.x = pk2(s[0 * 33], s[1 * 33]); o.y = pk2(s[2 * 33], s[3 * 33]); o.z = pk2(s[4 * 33], s[5 * 33]); o.w = pk2(s[6 * 33], s[7 * 33]);
        int nd = n0 + n; if (CONVPERM) nd = conv_perm(nd);
        *(u32x4*)(WT + (size_t)nd * K + k0 + 8 * c) = o;
    }
    LDS_WAIT(); asm volatile("" ::: "memory");
}
template <bool CONVPERM>
DI void transpose_all(const float* W, const float* gain, int K, int N, bf16* WT, LAS float* scr, int gw, int ngw, int lane_) {
    const int lane = launder(lane_);
    const int nitems = (K / 64) * (N / 32);
    for (int it = gw; it < nitems; it += ngw) transpose_item<CONVPERM>(W, gain, K, N, WT, scr, it, lane);
}
DI void x_to_bf16_rows(const float* x, bf16* h, float* RS, int gw, int ngw, int lane_) {
    const int lane = launder(lane_);
    for (int m = gw; m < M; m += ngw) {
        const f32x4* xr = (const f32x4*)(x + (size_t)m * DM) + lane;
        f32x4 v[8]; float s = 0.f;
#pragma unroll
        for (int j = 0; j < 8; ++j) { v[j] = xr[64 * j]; s += (v[j].x * v[j].x + v[j].y * v[j].y) + (v[j].z * v[j].z + v[j].w * v[j].w); }
        const float rs = rsqrtf(wave_sum(s) * (1.f / DM) + 1e-6f);
        u32x2* o = (u32x2*)(h + (size_t)m * DM) + lane;
#pragma unroll
        for (int j = 0; j < 8; ++j) { u32x2 w; w.x = pk2(v[j].x, v[j].y); w.y = pk2(v[j].z, v[j].w); o[64 * j] = w; }
        if (lane == 0) RS[m] = rs;
    }
}
DI void rs_phase(const float* PS, float* RS, int G, int blk) {
    for (int row = blk * NTHREADS + launder((int)threadIdx.x); row < M; row += G * NTHREADS) {
        const f32x4* p = (const f32x4*)(PS + (size_t)row * 32); float s = 0.f;
#pragma unroll
        for (int j = 0; j < 8; ++j) { const f32x4 v = p[j]; s += (v.x + v.y) + (v.z + v.w); }
        RS[row] = rsqrtf(s * (1.f / 2048.f) + 1e-6f);
    }
}
DI void conv_fix_phase(const bf16* VB, const bf16* BGB, bf16* Y, const float* cw, const float* cb, int G, int blk) {
    const int gtid = blk * NTHREADS + launder((int)threadIdx.x); const int stride = G * NTHREADS;
    const int ch = (gtid & 255) * 8;
    float w0[8], w1[8], w2[8], bb[8];
#pragma unroll
    for (int e = 0; e < 8; ++e) { w0[e] = cw[ch + e]; w1[e] = cw[2048 + ch + e]; w2[e] = cw[4096 + ch + e]; bb[e] = cb[ch + e]; }
    for (int idx = gtid; idx < (M / 64) * 2 * 256; idx += stride) {
        const int sj = idx >> 8, slab = sj >> 1, j = sj & 1;
        const bool first = (slab & 31) == 0;
        const u32x4 z = {0u, 0u, 0u, 0u};
        const u32x4 v0 = *(const u32x4*)(VB + ((size_t)slab * 4 + 2 + j) * 2048 + ch);
        const u32x4 v1 = j ? *(const u32x4*)(VB + ((size_t)slab * 4 + 2) * 2048 + ch) : (first ? z : *(const u32x4*)(VB + ((size_t)(slab - 1) * 4 + 1) * 2048 + ch));
        const u32x4 v2 = first ? z : *(const u32x4*)(VB + ((size_t)(slab - 1) * 4 + j) * 2048 + ch);
        const u32x4 bg = *(const u32x4*)(BGB + ((size_t)slab * 2 + j) * 2048 + ch);
        u32x4 o;
#pragma unroll
        for (int p = 0; p < 4; ++p) {
            const float c0 = bb[2 * p] + w0[2 * p] * bflo(v2[p]) + w1[2 * p] * bflo(v1[p]) + w2[2 * p] * bflo(v0[p]);
            const float c1 = bb[2 * p + 1] + w0[2 * p + 1] * bfhi(v2[p]) + w1[2 * p + 1] * bfhi(v1[p]) + w2[2 * p + 1] * bfhi(v0[p]);
            o[p] = pk2(bflo(bg[p]) * c0, bfhi(bg[p]) * c1);
        }
        *(u32x4*)(Y + ((size_t)slab * 64 + j) * 2048 + ch) = o;
    }
}

template <bool DRY>
DI void gn_phase(bf16* O, const bf16* Gt, const float* gw_, const float* gb_, int gw, int ngw, int lane_) {
    const int lane = launder(lane_);
    const int hd = gw & 7; const int c0 = hd * 512 + 8 * lane;
    float w[8], b[8];
#pragma unroll
    for (int e = 0; e < 8; ++e) { w[e] = gw_[c0 + e]; b[e] = gb_[c0 + e]; }
    for (int idx = gw; idx < M * 8; idx += ngw) {
        const size_t off = (size_t)(idx >> 3) * 4096 + c0;
        const u32x4 ov = *(const u32x4*)(O + off), gv = *(const u32x4*)(Gt + off);
        float x[8], g[8];
#pragma unroll
        for (int p = 0; p < 4; ++p) { x[2 * p] = bflo(ov[p]); x[2 * p + 1] = bfhi(ov[p]); g[2 * p] = bflo(gv[p]); g[2 * p + 1] = bfhi(gv[p]); }
        float s = 0.f;
#pragma unroll
        for (int e = 0; e < 8; ++e) s += x[e];
        const float mu = wave_sum(s) * (1.f / 512.f);
        float q = 0.f;
#pragma unroll
        for (int e = 0; e < 8; ++e) { x[e] -= mu; q += x[e] * x[e]; }
        const float rstd = rsqrtf(wave_sum(q) * (1.f / 512.f) + 1e-5f);
        u32x4 o;
#pragma unroll
        for (int p = 0; p < 4; ++p) {
            const float y0 = silu_f(g[2 * p]) * (x[2 * p] * rstd * w[2 * p] + b[2 * p]);
            const float y1 = silu_f(g[2 * p + 1]) * (x[2 * p + 1] * rstd * w[2 * p + 1] + b[2 * p + 1]);
            o[p] = pk2(y0, y1);
        }
        if (!DRY || rstd < 0.f) *(u32x4*)(O + off) = o;
    }
}

template <bool DRY>
DI void ret_phase(LAS unsigned char* lds, const bf16* Q, const bf16* Kb, bf16* V, const float* qg, const float* kg, int G, int blk) {
    const int tid = launder((int)threadIdx.x), lane = tid & 63, wid = __builtin_amdgcn_readfirstlane(tid >> 6);
    const int r = lane & 31, hh = lane >> 5, q4 = (lane & 15) >> 2, p4 = lane & 3, blk16 = (lane >> 4) & 1;
    const int c = wid & 3, dh = wid >> 2;
    constexpr int QP = 528, KQP = 576, VP = 320, PP = 144;
    constexpr int OFF_Q = 0, OFF_K = 64 * QP, OFF_V = 64 * QP + 64 * KQP, OFF_P = OFF_V + 64 * VP, OFF_R = OFF_P + 64 * PP;
    static_assert(OFF_R + 32768 <= LDS_BYTES - 64, "retention LDS map");
    const LAS unsigned char* Qi = lds + OFF_Q; const LAS unsigned char* Ki = lds + OFF_K; const LAS unsigned char* Vi = lds + OFF_V; const LAS unsigned char* Pi = lds + OFF_P;
    LAS float* Red = (LAS float*)(lds + OFF_R);
    const int srow = tid >> 4, sp = tid & 15, vr = tid >> 3, vp = tid & 7;
    u32x4 rq[4], rk[4], rv[2];
#define RET_LOAD(n_) do { _Pragma("unroll") for (int jj = 0; jj < 2; ++jj) { const size_t m_ = (size_t)b * SEQ + (n_) * 64 + srow + 32 * jj; \
            const bf16* qp_ = Q + m_ * 2048 + h * 256 + 8 * sp; const bf16* kp_ = Kb + m_ * 2048 + h * 256 + 8 * sp; \
            rq[2 * jj] = *(const u32x4*)qp_; rq[2 * jj + 1] = *(const u32x4*)(qp_ + 128); rk[2 * jj] = *(const u32x4*)kp_; rk[2 * jj + 1] = *(const u32x4*)(kp_ + 128); } \
        const bf16* vp_ = V + ((size_t)b * SEQ + (n_) * 64 + vr) * 4096 + h * 512 + vs * 128 + 8 * vp; rv[0] = *(const u32x4*)vp_; rv[1] = *(const u32x4*)(vp_ + 64); } while (0)
#define RET_STAGE() do { _Pragma("unroll") for (int jj = 0; jj < 2; ++jj) { const int row_ = srow + 32 * jj; \
            *(LAS u32x4*)(lds + OFF_Q + row_ * QP + 16 * sp) = rq[2 * jj]; *(LAS u32x4*)(lds + OFF_Q + row_ * QP + 256 + 16 * sp) = rq[2 * jj + 1]; \
            *(LAS u32x4*)(lds + OFF_K + row_ * KQP + 16 * sp) = rk[2 * jj]; *(LAS u32x4*)(lds + OFF_K + row_ * KQP + 256 + 16 * sp) = rk[2 * jj + 1]; } \
        *(LAS u32x4*)(lds + OFF_V + vr * VP + 16 * vp) = rv[0]; *(LAS u32x4*)(lds + OFF_V + vr * VP + 128 + 16 * vp) = rv[1]; } while (0)
    for (int it = blk; it < 512; it += G) {
        const int loc = it & 255, rnd = it >> 8;
        const int vs = (loc >> 3) & 3, bh = rnd * 64 + (loc & 7) * 8 + (loc >> 5);
        const int b = bh >> 3, h = bh & 7;
        const float gam = 1.f - exp2f(-5.f - (float)h), l2g = log2f(gam), gC = exp2f(64.f * l2g);
        f32x16 st[4];
#pragma unroll
        for (int d = 0; d < 4; ++d)
#pragma unroll
            for (int i = 0; i < 16; ++i) st[d][i] = 0.f;
        RET_LOAD(0);
        for (int n = 0; n < 32; ++n) {
            const int t0 = n * 64;
            RET_STAGE();
            __syncthreads();
            if (n < 31) RET_LOAD(n + 1);
            if (wid < 3) {
                const int kt = (wid == 2) ? 1 : 0, qt = (wid >= 1) ? 1 : 0;
                f32x16 X;
#pragma unroll
                for (int i = 0; i < 16; ++i) X[i] = 0.f;
                const LAS unsigned char* ka = Ki + (32 * kt + r) * KQP + 16 * hh; const LAS unsigned char* qa = Qi + (32 * qt + r) * QP + 16 * hh;
#pragma unroll
                for (int s4 = 0; s4 < 4; ++s4) {
                    bf16x8 Af[4], Bf[4];
#pragma unroll
                    for (int s = 0; s < 4; ++s) { Af[s] = *(const LAS bf16x8*)(ka + 32 * (4 * s4 + s)); Bf[s] = *(const LAS bf16x8*)(qa + 32 * (4 * s4 + s)); }
                    __builtin_amdgcn_sched_barrier(0);
#pragma unroll
                    for (int s = 0; s < 4; ++s) X = MFMA32(Af[s], Bf[s], X);
                }
                if (kt == qt) {
#pragma unroll
                    for (int i = 0; i < 16; ++i) if (crow(i, hh) > r) X[i] = 0.f;
                }
#pragma unroll
                for (int g = 0; g < 4; ++g) { u32x2 w; w.x = pk2(X[4 * g], X[4 * g + 1]); w.y = pk2(X[4 * g + 2], X[4 * g + 3]);
                    *(LAS u32x2*)(lds + OFF_P + (32 * qt + r) * PP + 2 * (32 * kt + 8 * g + 4 * hh)) = w; }
            }
            f32x16 Op[2];
#pragma unroll
            for (int i = 0; i < 16; ++i) { Op[0][i] = 0.f; Op[1][i] = 0.f; }
#pragma unroll
            for (int dt = 0; dt < 4; ++dt) {
                const bf16x8 B0 = pack_step<0>(st[dt]), B1 = pack_step<1>(st[dt]);
                s16x4 qf[2][4];
#pragma unroll
                for (int qt = 0; qt < 2; ++qt) {
                    const LAS unsigned char* qa = Qi + (32 * qt + r) * QP + 2 * (128 * dh + 32 * dt + 4 * hh);
                    qf[qt][0] = *(const LAS s16x4*)(qa); qf[qt][1] = *(const LAS s16x4*)(qa + 16); qf[qt][2] = *(const LAS s16x4*)(qa + 32); qf[qt][3] = *(const LAS s16x4*)(qa + 48);
                }
                __builtin_amdgcn_sched_barrier(0);
#pragma unroll
                for (int qt = 0; qt < 2; ++qt) {
                    Op[qt] = MFMA32(__builtin_shufflevector(qf[qt][0], qf[qt][1], 0, 1, 2, 3, 4, 5, 6, 7), B0, Op[qt]);
                    Op[qt] = MFMA32(__builtin_shufflevector(qf[qt][2], qf[qt][3], 0, 1, 2, 3, 4, 5, 6, 7), B1, Op[qt]);
                }
            }
            __syncthreads();
#pragma unroll
            for (int qt = 0; qt < 2; ++qt) {
                if (dh <= qt) {
#pragma unroll
                    for (int s = 0; s < 2; ++s) {
                        const bf16x8 A = *(const LAS bf16x8*)(Pi + (32 * qt + r) * PP + 2 * (32 * dh + 16 * s + 8 * hh));
                        const int rb = 32 * dh + 16 * s + 8 * hh;
                        const bf16x8 B = tr_frag(Vi, VP, rb, rb + 4, 2 * (32 * c + 16 * blk16 + 4 * p4), q4);
                        Op[qt] = MFMA32(A, B, Op[qt]);
                    }
                }
            }
            {
                bf16x8 Bv[4];
#pragma unroll
                for (int s = 0; s < 4; ++s) { const int rb = 16 * s + 8 * hh; Bv[s] = tr_frag(Vi, VP, rb, rb + 4, 2 * (32 * c + 16 * blk16 + 4 * p4), q4); }
#pragma unroll
                for (int dt = 0; dt < 4; ++dt) {
                    bf16x8 Ak[4];
#pragma unroll
                    for (int s = 0; s < 4; ++s) { const int rb = 16 * s + 8 * hh; Ak[s] = tr_frag(Ki, KQP, rb, rb + 4, 2 * (128 * dh + 32 * dt + 16 * blk16 + 4 * p4), q4); }
                    __builtin_amdgcn_sched_barrier(0);
#pragma unroll
                    for (int s = 0; s < 4; ++s) st[dt] = MFMA32(Ak[s], Bv[s], st[dt]);
#pragma unroll
                    for (int i = 0; i < 16; ++i) st[dt][i] *= gC;
                }
            }
            if (dh == 1) {
#pragma unroll
                for (int qt = 0; qt < 2; ++qt)
#pragma unroll
                    for (int i = 0; i < 16; ++i) Red[c * 2048 + (32 * qt + crow(i, hh)) * 32 + r] = Op[qt][i];
            }
            __syncthreads();
            if (dh == 0 && (!DRY || gC > 2.f)) {
#pragma unroll
                for (int qt = 0; qt < 2; ++qt)
#pragma unroll
                    for (int i = 0; i < 16; ++i) {
                        const int q = 32 * qt + crow(i, hh);
                        const float v = Op[qt][i] + Red[c * 2048 + q * 32 + r];
                        V[((size_t)b * SEQ + t0 + q) * 4096 + h * 512 + vs * 128 + 32 * c + r] = f2bf(v);
                    }
            }
        }
    }
}

#undef RET_LOAD
#undef RET_STAGE
DI void sb_phase(LAS unsigned char* lds, const bf16* Q, const bf16* Kb, const bf16* Vb, const bf16* Gb, bf16* Y, const float* qg, const float* kg, int G, int blk) {
    const int tid = launder((int)threadIdx.x), lane = tid & 63, wid = __builtin_amdgcn_readfirstlane(tid >> 6);
    const int r = lane & 31, hh = lane >> 5, q4 = (lane & 15) >> 2, p4 = lane & 3, blk16 = (lane >> 4) & 1;
    volatile LAS unsigned* alive = (volatile LAS unsigned*)(lds + LDS_BYTES - 64) + 4;
    constexpr int KP = 272, TB = 64 * KP, VPs = 320, TBV = 64 * VPs;
    const int kr = tid >> 3, kp8 = tid & 7;
    for (int bh = blk; bh < 256; bh += G) {
        u32x4 pk1, pk2_, pv1, pv2;
        bf16x8 Qf[8];
        for (int qb = 7; qb >= 0; --qb) {
            const int b = bh >> 4, h = bh & 15, q0 = 256 * qb;
            const int r_l = launder(r), hh_l = launder(hh), lane_l = launder(lane);
            if (qb == 7) {
                const bf16* qp = Q + ((size_t)b * SEQ + q0 + 32 * wid + r_l) * 2048 + h * 128 + 8 * hh_l;
#pragma unroll
                for (int s = 0; s < 8; ++s) Qf[s] = *(const bf16x8*)(qp + 16 * s);
            }
            f32x16 O[4];
#pragma unroll
            for (int d = 0; d < 4; ++d)
#pragma unroll
                for (int i = 0; i < 16; ++i) O[d][i] = 0.f;
            float R = 1.f;
            const int ktmax = 4 * qb + 3, stmax = 8 * qb + wid;
#define SB_LOAD(kt_) do { const size_t m_ = (size_t)b * SEQ + 64 * (kt_) + kr; const bf16* kp_ = Kb + m_ * 2048 + h * 128 + 8 * kp8; const bf16* vp_ = Vb + m_ * 2048 + h * 128 + 8 * kp8; \
        pk1 = *(const u32x4*)kp_; pk2_ = *(const u32x4*)(kp_ + 64); pv1 = *(const u32x4*)vp_; pv2 = *(const u32x4*)(vp_ + 64); } while (0)
#define SB_STORE(buf_) do { LAS unsigned char* kb_ = lds + (buf_) * TB + kr * KP + 16 * kp8; LAS unsigned char* vb_ = lds + 2 * TB + (buf_) * TBV + kr * VPs + 16 * kp8; \
        *(LAS u32x4*)kb_ = pk1; *(LAS u32x4*)(kb_ + 128) = pk2_; *(LAS u32x4*)vb_ = pv1; *(LAS u32x4*)(vb_ + 128) = pv2; } while (0)
            if (qb == 7) SB_LOAD(ktmax);
            SB_STORE(0);
            if (tid < 3) alive[tid] = 0u;
            __syncthreads();
            int cur = 0;
            bool wdone = false;
            for (int kt = ktmax; kt >= 0; --kt) {
                if (kt < ktmax && alive[(kt + 1) % 3] == 0u) break;
                if (tid == 0) alive[(kt + 2) % 3] = 0u;
                if (kt > 0) SB_LOAD(kt - 1);
                const LAS unsigned char* Kimg = lds + cur * TB; const LAS unsigned char* Vimg = lds + 2 * TB + cur * TBV;
#define SB_SUBTILE(ss_) do { \
                        bf16x8 Kf[8]; \
                        { const LAS unsigned char* ka = Kimg + (32 * (ss_) + r) * KP + 16 * hh; \
                          _Pragma("unroll") for (int s = 0; s < 8; ++s) Kf[s] = *(const LAS bf16x8*)(ka + 32 * s); } \
                        __builtin_amdgcn_sched_barrier(0); \
                        f32x16 X; \
                        _Pragma("unroll") for (int i = 0; i < 16; ++i) X[i] = 0.f; \
                        _Pragma("unroll") for (int s = 0; s < 8; ++s) X = MFMA32(Kf[s], Qf[s], X); \
                        if (2 * kt + (ss_) == stmax) {     \
                            _Pragma("unroll") for (int i = 0; i < 16; ++i) if (crow(i, hh) >= r) X[i] = -1e30f; } \
                        bf16x8 Vf[8]; \
                        _Pragma("unroll") for (int dvt = 0; dvt < 4; ++dvt) { const int cb = 2 * (32 * dvt + 16 * blk16 + 4 * p4); \
                            Vf[2 * dvt] = tr_frag(Vimg, VPs, 32 * (ss_) + 4 * hh, 32 * (ss_) + 8 + 4 * hh, cb, q4); \
                            Vf[2 * dvt + 1] = tr_frag(Vimg, VPs, 32 * (ss_) + 16 + 4 * hh, 32 * (ss_) + 24 + 4 * hh, cb, q4); } \
                        __builtin_amdgcn_sched_barrier(0); \
                          \
                        float lf[16]; \
                        _Pragma("unroll") for (int i = 0; i < 16; ++i) { const float e = __builtin_amdgcn_exp2f(X[i]); X[i] = e; lf[i] = __builtin_amdgcn_rcpf(1.f + e); } \
                        float gs[4], ot[4], off[4]; \
                        _Pragma("unroll") for (int g = 0; g < 4; ++g) { lf[4 * g + 2] *= lf[4 * g + 3]; lf[4 * g + 1] *= lf[4 * g + 2]; lf[4 * g] *= lf[4 * g + 1]; gs[g] = lf[4 * g]; } \
                        _Pragma("unroll") for (int g = 0; g < 4; ++g) { const unsigned gi = __builtin_bit_cast(unsigned, gs[g]); \
                            const auto sw = __builtin_amdgcn_permlane32_swap(gi, gi, false, false); ot[g] = __builtin_bit_cast(float, hh ? sw[0] : sw[1]); } \
                        float hi_ = R; \
                        _Pragma("unroll") for (int g = 3; g >= 0; --g) { off[g] = hi_ * (hh == 0 ? ot[g] : 1.f); hi_ *= gs[g] * ot[g]; } \
                        _Pragma("unroll") for (int i = 0; i < 16; ++i) X[i] = X[i] * (off[i >> 2] * lf[i]); \
                        R = hi_; \
                        const bf16x8 A0 = pack_step<0>(X), A1 = pack_step<1>(X); \
                        _Pragma("unroll") for (int dvt = 0; dvt < 4; ++dvt) { O[dvt] = MFMA32(A0, Vf[2 * dvt], O[dvt]); O[dvt] = MFMA32(A1, Vf[2 * dvt + 1], O[dvt]); } \
                    } while (0)
                if (2 * kt + 1 <= stmax && !wdone) SB_SUBTILE(1);
                if (2 * kt <= stmax && !wdone) { SB_SUBTILE(0); wdone = (__builtin_amdgcn_ballot_w64(R != 0.f) == 0ull); }
                if (!wdone && lane == 0) alive[kt % 3] = 1u;
#undef SB_SUBTILE
                if (kt > 0) SB_STORE(cur ^ 1);
                __syncthreads();
                cur ^= 1;
            }
            if (qb > 0) {
                SB_LOAD(4 * (qb - 1) + 3);
                const bf16* qp = Q + ((size_t)b * SEQ + q0 - 256 + 32 * wid + r_l) * 2048 + h * 128 + 8 * hh_l;
#pragma unroll
                for (int s = 0; s < 8; ++s) Qf[s] = *(const bf16x8*)(qp + 16 * s);
            }
#undef SB_LOAD
#undef SB_STORE
            {
                LAS unsigned char* Ow = lds + 2 * TB + 2 * TBV + wid * (32 * KP);
                const int pc = lane_l & 15, rw = lane_l >> 4;
                const bf16* gp = Gb + ((size_t)b * SEQ + q0 + 32 * wid + rw) * 2048 + h * 128 + 8 * pc;
                bf16* yp = Y + ((size_t)b * SEQ + q0 + 32 * wid + rw) * 2048 + h * 128 + 8 * pc;
                u32x4 gv[8];
#pragma unroll
                for (int j = 0; j < 8; ++j) gv[j] = *(const u32x4*)(gp + (size_t)j * 4 * 2048);
#pragma unroll
                for (int dvt = 0; dvt < 4; ++dvt)
#pragma unroll
                    for (int i = 0; i < 16; ++i) *(LAS bf16*)(Ow + crow(i, hh) * KP + 2 * (32 * dvt + r)) = f2bf(O[dvt][i]);
                LDS_WAIT(); asm volatile("" ::: "memory");
#pragma unroll
                for (int j = 0; j < 8; ++j) {
                    const u32x4 ov = *(const LAS u32x4*)(Ow + (rw + 4 * j) * KP + 16 * pc);
                    u32x4 yo;
#pragma unroll
                    for (int p = 0; p < 4; ++p) yo[p] = pk2(silu_f(bflo(gv[j][p])) * bflo(ov[p]), silu_f(bfhi(gv[j][p])) * bfhi(ov[p]));
                    *(u32x4*)(yp + (size_t)j * 4 * 2048) = yo;
                }
                LDS_WAIT(); asm volatile("" ::: "memory");
            }
        }
    }
}

#define XB_TMO      128
#define XB_XCNT(j)  (256  + 64 * (j))
#define XB_XSUB(j)  (1280 + 64 * (j))
#define XB_XGEN(j)  (2304 + 64 * (j))
#define XB_TOP      3328
#define XB_TOPGEN   3392
#define XCD_BAR_WORDS 3456
#define XB_SPIN_CAP (1u << 18)

__device__ __forceinline__ unsigned xb_ld(unsigned* p)              { return __hip_atomic_load(p, __ATOMIC_RELAXED, __HIP_MEMORY_SCOPE_AGENT); }
__device__ __forceinline__ unsigned xb_add(unsigned* p, unsigned v) { return __hip_atomic_fetch_add(p, v, __ATOMIC_RELAXED, __HIP_MEMORY_SCOPE_AGENT); }
__device__ __forceinline__ unsigned xb_xcc_id() { return (unsigned)__builtin_amdgcn_s_getreg((3 << 11) | 20) & 0xFu; }
#define XB_SPIN(cond, bar) do { unsigned _sp = 0; while (cond) { __builtin_amdgcn_s_sleep(1); \
    if ((++_sp & 255u) == 0u) { if (xb_ld(&(bar)[XB_TMO])) break; if (_sp > XB_SPIN_CAP) { atomicAdd(&(bar)[XB_TMO], 1u); break; } } } } while (0)

struct XcdBarrier {
    unsigned* bar; unsigned x;
    volatile LAS unsigned* st;
};

__device__ __forceinline__ XcdBarrier xcd_barrier_post(unsigned* bar, volatile LAS unsigned* st) {
    XcdBarrier b; b.bar = bar; b.x = xb_xcc_id(); b.st = st;
    if (threadIdx.x == 0) (void)xb_add(&bar[XB_XCNT(b.x)], 1u);
    return b;
}
__device__ __forceinline__ void xcd_barrier_complete(unsigned* bar, unsigned x, unsigned& nloc, unsigned& nx) {
    const unsigned G = gridDim.x * gridDim.y * gridDim.z;
    unsigned sum, cnt, mine, sp = 0u;
    for (;;) {
        sum = 0u; cnt = 0u; mine = 0u;
#pragma unroll
        for (unsigned j = 0; j < 16; ++j) { const unsigned c = xb_ld(&bar[XB_XCNT(j)]); sum += c; cnt += (c > 0u) ? 1u : 0u; mine = (j == x) ? c : mine; }
        if (sum == G) break;
        __builtin_amdgcn_s_sleep(1);
        if ((++sp & 255u) == 0u) { if (xb_ld(&bar[XB_TMO])) break; if (sp > XB_SPIN_CAP) { atomicAdd(&bar[XB_TMO], 1u); break; } }
    }
    nloc = mine > 0u ? mine : 1u; nx = cnt > 0u ? cnt : 1u;
}

__device__ __forceinline__ void xcd_barrier(const XcdBarrier& b) {
    asm volatile("s_waitcnt vmcnt(0)" ::: "memory");
    __syncthreads();
    if (threadIdx.x == 0) {
        unsigned* bar = b.bar;
        __builtin_amdgcn_s_waitcnt(0);
        unsigned nloc = b.st[0], nx = b.st[1];
        if (nloc == 0u) { xcd_barrier_complete(bar, b.x, nloc, nx); b.st[0] = nloc; b.st[1] = nx; }
        const unsigned old = xb_add(&bar[XB_XSUB(b.x)], 1u);
        const unsigned gen = old / nloc;
        if (old + 1u == (gen + 1u) * nloc) {
            __builtin_amdgcn_fence(__ATOMIC_RELEASE, "agent");
            asm volatile("s_waitcnt vmcnt(0)" ::: "memory");
            const unsigned og = xb_add(&bar[XB_TOP], 1u);
            const unsigned tg = og / nx;
            if (og + 1u == (tg + 1u) * nx) xb_add(&bar[XB_TOPGEN], 1u);
            else XB_SPIN(xb_ld(&bar[XB_TOPGEN]) == tg, bar);
            __builtin_amdgcn_fence(__ATOMIC_ACQUIRE, "agent");
            xb_add(&bar[XB_XGEN(b.x)], 1u);
            asm volatile("s_waitcnt vmcnt(0)" ::: "memory");
        } else {
            XB_SPIN(xb_ld(&bar[XB_XGEN(b.x)]) == gen, bar);
            __builtin_amdgcn_fence(__ATOMIC_ACQUIRE, "agent");
            asm volatile("s_waitcnt vmcnt(0)" ::: "memory");
        }
    }
    __syncthreads();
}

struct ProbeOrder : pg8::StaticOrder {
    int reps;
    __device__ bool next(int i, pg8::Unit& u) const { const int cnt = (nwg - c + G - 1) / G; if (i >= reps * cnt) return false; return pg8::StaticOrder::next(i % cnt, u); }
};
struct Args { const float* in[18]; float* out; unsigned char* ws; int ph_lo, ph_hi; };
__global__ void __launch_bounds__(NTHREADS, 2) hybrid_fwd(Args args) {
    extern __shared__ __attribute__((aligned(16))) unsigned char lds_raw[];
    LAS unsigned char* lds = (LAS unsigned char*)lds_raw;
    const int tid = threadIdx.x, lane = tid & 63, wave = __builtin_amdgcn_readfirstlane(tid >> 6);
    const int G = gridDim.x, blk = blockIdx.x;
    const int gw = blk * NWAVES + wave, ngw = G * NWAVES;
    unsigned char* ws = args.ws;
    const float* x_in = args.in[0];
    float* xo = args.out;
    bf16* WA_in = (bf16*)(ws + WS_WA); bf16* WA_out = (bf16*)(ws + WS_WA + 32 * MiB);
    bf16* WB_in = (bf16*)(ws + WS_WB); bf16* WB_out_ret = (bf16*)(ws + WS_WB + 48 * MiB); bf16* WB_out_conv = (bf16*)(ws + WS_WB + 32 * MiB);
    bf16* H = (bf16*)(ws + WS_H);
    bf16* P0 = (bf16*)(ws + WS_P); bf16* P1 = (bf16*)(ws + WS_P + 128 * MiB); bf16* P2 = (bf16*)(ws + WS_P + 256 * MiB);
    bf16* P3 = (bf16*)(ws + WS_P + 384 * MiB); bf16* P4 = (bf16*)(ws + WS_P + 512 * MiB);
    LAS float* scr = (LAS float*)(lds + wave * 16384);
    const int lo = args.ph_lo, hi = args.ph_hi;
    volatile LAS unsigned* misc = (volatile LAS unsigned*)(lds + LDS_BYTES - 64);
    if (tid < 16) misc[tid] = 0u;
    __syncthreads();
    XcdBarrier bar; bar.bar = (unsigned*)ws; bar.x = 0; bar.st = nullptr;
    if (!MK_PER_PHASE) bar = xcd_barrier_post((unsigned*)ws, misc);
#define IN(k) (lo <= (k) && (k) < hi)
#define SEAM(k) do { if (IN(k) && IN((k) + 1)) { if ((k) == 0) cg::this_grid().sync(); else xcd_barrier(bar); } } while (0)
#define GEMM_PHASE(EPI, Aptr, Bptr, N_, K_, ...) do { pg8::Gemm g{(const pg8::bf16_t*)(Aptr), (const pg8::bf16_t*)(Bptr), M, (N_), (K_)}; pg8::StaticOrder S; S.init(M, (N_), G, blk); \
        pg8::EPI E{__VA_ARGS__}; pg8::gemm_phase<pg8::EPI, pg8::StaticOrder, false, GEMM_SP2>(lds, g, S, E); } while (0)

#define GEMM_PHASE_P(EPI, Aptr, Bptr, N_, K_, ...) do { pg8::Gemm g{(const pg8::bf16_t*)(Aptr), (const pg8::bf16_t*)(Bptr), M, (N_), (K_)}; ProbeOrder S; S.init(M, (N_), G, blk); S.reps = ((PROBE == 1 || (PROBE == 5 && (K_) == 2048 && (N_) == 2048)) ? 2 : 1); \
        pg8::EPI E{__VA_ARGS__}; pg8::gemm_phase<pg8::EPI, ProbeOrder, GEMM_ALIGN, GEMM_SP2>(lds, g, S, E); } while (0)
    float* RS = (float*)(ws + 65536); float* PS = (float*)(ws + WS_PS); bf16* VBH = (bf16*)(ws + WS_PS + 4 * MiB); bf16* BGH = (bf16*)(ws + WS_PS + 12 * MiB);
    if (IN(0)) for (int rep = 0; rep < (PROBE == 4 ? 2 : 1); ++rep) {
        if (wave & 1) x_to_bf16_rows(x_in, H, RS, gw, ngw, lane);
        transpose_all<true>(args.in[2], args.in[1], 2048, 8192, WA_in, scr, gw, ngw, lane);
        transpose_all<false>(args.in[5], nullptr, 2048, 2048, WA_out, scr, gw, ngw, lane);
        transpose_all<false>(args.in[7], args.in[6], 2048, 12288, WB_in, scr, gw, ngw, lane);
        transpose_all<false>(args.in[12], nullptr, 4096, 2048, WB_out_ret, scr, gw, ngw, lane);
        if (!(wave & 1)) x_to_bf16_rows(x_in, H, RS, gw, ngw, lane);
    }
    SEAM(0);
    if (IN(1)) GEMM_PHASE_P(EpiConvFused, H, WA_in, 8192, 2048, P2, VBH, BGH, RS, args.in[3], args.in[4]);
    SEAM(1);
    if (IN(2)) { if (PROBE == 10) for (int q = 0; q < 20; ++q) xcd_barrier(bar); conv_fix_phase(VBH, BGH, P2, args.in[3], args.in[4], G, blk); }
    SEAM(2);
    if (IN(3)) { if (PROBE == 5) GEMM_PHASE_P(EpiResid, P2, WA_out, 2048, 2048, H, nullptr, H, PS); else GEMM_PHASE(EpiResid, P2, WA_out, 2048, 2048, H, nullptr, H, PS); }
    SEAM(3);
    if (IN(4)) rs_phase(PS, RS, G, blk);
    SEAM(4);
    if (IN(5)) GEMM_PHASE_P(EpiSplitRet, H, WB_in, 12288, 2048, P0, P1, P2, P4, RS, args.in[8], args.in[9], (LAS float*)(lds + 131072));
    SEAM(5);
    if (IN(6)) { if (PROBE == 2) { ret_phase<true>(lds, P0, P1, P2, args.in[8], args.in[9], G, blk); __syncthreads(); } ret_phase<false>(lds, P0, P1, P2, args.in[8], args.in[9], G, blk); }
    SEAM(6);
    if (IN(7)) {
        if (PROBE == 2) gn_phase<true>(P2, P4, args.in[10], args.in[11], gw, ngw, lane);
        gn_phase<false>(P2, P4, args.in[10], args.in[11], gw, ngw, lane);
        transpose_all<false>(args.in[14], args.in[13], 2048, 8192, WA_in, scr, gw, ngw, lane);
        transpose_all<false>(args.in[17], nullptr, 2048, 2048, WA_out, scr, gw, ngw, lane);
    }
    SEAM(7);
    if (IN(8)) GEMM_PHASE(EpiResid, P2, WB_out_ret, 2048, 4096, H, nullptr, H, PS);
    SEAM(8);
    if (IN(9)) rs_phase(PS, RS, G, blk);
    SEAM(9);
    if (IN(10)) GEMM_PHASE_P(EpiSplitSb, H, WA_in, 8192, 2048, P0, P1, P2, P3, RS, args.in[15], args.in[16], (LAS float*)(lds + 131072));
    SEAM(10);
    if (IN(11)) {
        transpose_all<true>(args.in[2] + (size_t)2048 * 8192, args.in[1] + 2048, 2048, 8192, WB_in, scr, gw, ngw, lane);
        transpose_all<false>(args.in[5] + (size_t)2048 * 2048, nullptr, 2048, 2048, WB_out_conv, scr, gw, ngw, lane);
        for (int rep = 0; rep < (PROBE == 3 ? 2 : 1); ++rep) { __syncthreads(); sb_phase(lds, P0, P1, P2, P3, P4, args.in[15], args.in[16], G, blk); }
    }
    SEAM(11);
    if (IN(12)) GEMM_PHASE(EpiResid, P4, WA_out, 2048, 2048, H, nullptr, H, PS);
    SEAM(12);
    if (IN(13)) rs_phase(PS, RS, G, blk);
    SEAM(13);
    if (IN(14)) GEMM_PHASE_P(EpiConvFused, H, WB_in, 8192, 2048, P2, VBH, BGH, RS, args.in[3] + 3 * 2048, args.in[4] + 2048);
    SEAM(14);
    if (IN(15)) conv_fix_phase(VBH, BGH, P2, args.in[3] + 3 * 2048, args.in[4] + 2048, G, blk);
    SEAM(15);
    if (IN(16)) GEMM_PHASE(EpiResid, P2, WB_out_conv, 2048, 2048, H, xo, nullptr, nullptr);
#undef IN
#undef SEAM
#undef GEMM_PHASE
}

extern "C" void kernel_launch(void* const* d_in, const int* in_sizes, int n_in, void* d_out, int out_size, void* d_ws, size_t ws_size, hipStream_t stream) {
    static int ready = 0;
    if (ready == 0) {
        if (n_in != 18 || in_sizes[0] != M * DM || out_size != M * DM || ws_size < WS_END) {
            fprintf(stderr, "kernel_launch: unexpected problem shape / workspace (n_in %d, in0 %d, out %d, ws %zu); nothing launched\n", n_in, n_in > 0 ? in_sizes[0] : -1, out_size, ws_size);
            ready = -1; return;
        }
        if (hipFuncSetAttribute((const void*)hybrid_fwd, hipFuncAttributeMaxDynamicSharedMemorySize, LDS_BYTES) != hipSuccess) { fprintf(stderr, "kernel_launch: hipFuncSetAttribute failed\n"); ready = -1; return; }
        int per_cu = 0;
        if (hipOccupancyMaxActiveBlocksPerMultiprocessor(&per_cu, (const void*)hybrid_fwd, NTHREADS, LDS_BYTES) != hipSuccess || per_cu < 1) fprintf(stderr, "kernel_launch: occupancy query says %d blocks/CU\n", per_cu);
        (void)hipGetLastError();
        ready = 1;
    }
    if (ready < 0) return;
    if (hipMemsetAsync(d_ws, 0, 65536, stream) != hipSuccess) { fprintf(stderr, "kernel_launch: hipMemsetAsync of the barrier words failed\n"); return; }
    Args a{};
    for (int i = 0; i < 18; ++i) a.in[i] = (const float*)d_in[i];
    a.out = (float*)d_out; a.ws = (unsigned char*)d_ws;
    const int grid = 256;
#if MK_PER_PHASE
    for (int p = 0; p < NPHASE; ++p) { a.ph_lo = p; a.ph_hi = p + 1; hipLaunchKernelGGL(hybrid_fwd, dim3(grid), dim3(NTHREADS), LDS_BYTES, stream, a); }
#else
    a.ph_lo = 0; a.ph_hi = NPHASE;
    void* kargs[] = {&a};
    hipError_t e = hipLaunchCooperativeKernel((const void*)hybrid_fwd, dim3(grid), dim3(NTHREADS), kargs, LDS_BYTES, stream);
    if (e != hipSuccess) fprintf(stderr, "kernel_launch: cooperative launch failed: %s\n", hipGetErrorString(e));
#endif
}
```
